# Optimizing an MI355X kernel written in HIP

```python
import jax, jax.numpy as jnp
from jax import lax
import numpy as np

D_MODEL = 1024
BATCH = 4
SEQ = 8192
DEPTH = 4

N_A = DEPTH // 2
N_B = DEPTH - N_A
N_HEADS = 16
HEAD_DIM = D_MODEL // N_HEADS
CONV_WIDTH = 3
D_FF = ((8 * D_MODEL // 3 + 255) // 256) * 256
DILATED_GROUPS = ((128, 1), (512, 4), (2048, 16))
BLOCK = 128
EPS = 1e-6

kernel_name = "yoco_shortconv_dilated_alibi_trunk"


def _rms_norm(x, g):
    xf = x.astype(jnp.float32)
    y = xf * lax.rsqrt(jnp.mean(xf * xf, axis=-1, keepdims=True) + EPS)
    return (y * g.astype(jnp.float32)).astype(x.dtype)


def _swiglu(x, w_in, w_out):
    gate, up = jnp.split(x @ w_in, 2, axis=-1)
    return (jax.nn.silu(gate) * up) @ w_out


def _short_conv(x, w_in, w_conv, w_out):
    b_gate, c_gate, h = jnp.split(x @ w_in, 3, axis=-1)
    u = c_gate * h
    u = lax.conv_general_dilated(
        u, w_conv[:, None, :].astype(u.dtype), window_strides=(1,),
        padding=[(CONV_WIDTH - 1, 0)],
        dimension_numbers=("NWC", "WIO", "NWC"),
        feature_group_count=D_MODEL)
    return (b_gate * u) @ w_out


def _alibi_slopes():
    h = np.arange(N_HEADS, dtype=np.float32) + 1.0
    return jnp.asarray(np.power(2.0, -8.0 * h / N_HEADS), dtype=jnp.float32)


def _strided_blocks(t, dilation):
    b, s, h, e = t.shape
    mult = dilation * BLOCK
    sp = -(-s // mult) * mult
    t = jnp.pad(t, ((0, 0), (0, sp - s), (0, 0), (0, 0)))
    return t.reshape(b, sp // mult, BLOCK, dilation, h, e)


def _with_prev_block(tb):
    prev = jnp.concatenate([jnp.zeros_like(tb[:, :1]), tb[:, :-1]], axis=1)
    return jnp.concatenate([prev, tb], axis=2)


def _shared_kv(h, g_kv, w_kv):
    b, s, _ = h.shape
    k, v = jnp.split(_rms_norm(h, g_kv) @ w_kv, 2, axis=-1)
    k = k.reshape(b, s, N_HEADS, HEAD_DIM)
    v = v.reshape(b, s, N_HEADS, HEAD_DIM)
    return [(_with_prev_block(_strided_blocks(k, d)), _with_prev_block(_strided_blocks(v, d)))
            for (_, d) in DILATED_GROUPS]


def _branch_attention(q, k_cat, v_cat, slopes, window, dilation):
    b, s, h, e = q.shape
    qb = _strided_blocks(q, dilation)
    nb = qb.shape[1]
    sc = jnp.einsum("bnqrhe,bnkrhe->bnrhqk", qb, k_cat).astype(jnp.float32)
    u = jnp.arange(BLOCK)[:, None]
    kk = jnp.arange(2 * BLOCK)[None, :]
    delta = u + BLOCK - kk
    band = (delta >= 0) & (delta <= window // dilation)
    first = (jnp.arange(nb) == 0)[:, None, None]
    valid = band[None] & ~(first & (kk < BLOCK)[None])
    bias = -slopes[:, None, None] * (delta * dilation).astype(jnp.float32)[None]
    sc = jnp.where(valid[:, None, None], sc + bias, -jnp.inf)
    m = jnp.max(sc, axis=-1, keepdims=True)
    p = jnp.exp(sc - m)
    den = jnp.sum(p, axis=-1, keepdims=True)
    o = jnp.einsum("bnrhqk,bnkrhe->bnqrhe", p / den, v_cat.astype(jnp.float32))
    lse = (m + jnp.log(den))[..., 0]
    o = o.reshape(b, nb * BLOCK * dilation, h, e)[:, :s]
    lse = lse.transpose(0, 1, 4, 2, 3).reshape(b, nb * BLOCK * dilation, h)[:, :s]
    return o, lse


def _dilated_attention(x, w_q, w_o, shared, slopes):
    b, s, _ = x.shape
    q = (x @ w_q).reshape(b, s, N_HEADS, HEAD_DIM) * (HEAD_DIM ** -0.5)
    outs, lses = [], []
    for (window, dil), (k_cat, v_cat) in zip(DILATED_GROUPS, shared):
        o, l = _branch_attention(q, k_cat, v_cat, slopes, window, dil)
        outs.append(o)
        lses.append(l)
    wts = jax.nn.softmax(jnp.stack(lses), axis=0)
    o = jnp.sum(wts[..., None] * jnp.stack(outs), axis=0)
    return o.reshape(b, s, D_MODEL).astype(x.dtype) @ w_o


def setup_inputs(seed: int = 0) -> dict:
    key = jax.random.key(seed)
    ks = jax.random.split(key, 12)
    f32 = jnp.float32
    nrm = lambda k, shape, fan_in: jax.random.normal(k, shape, f32) * (fan_in ** -0.5)
    return {
        "x": jax.random.normal(ks[0], (BATCH, SEQ, D_MODEL), f32),
        "norm_g": 1.0 + 0.05 * jax.random.normal(ks[1], (DEPTH, 4, D_MODEL), f32),
        "conv_in_w": nrm(ks[2], (N_A, D_MODEL, 3 * D_MODEL), D_MODEL),
        "conv_w": nrm(ks[3], (N_A, CONV_WIDTH, D_MODEL), CONV_WIDTH),
        "conv_out_w": nrm(ks[4], (N_A, D_MODEL, D_MODEL), D_MODEL),
        "kv_norm_g": 1.0 + 0.05 * jax.random.normal(ks[5], (D_MODEL,), f32),
        "kv_w": nrm(ks[6], (D_MODEL, 2 * D_MODEL), D_MODEL),
        "q_w": nrm(ks[7], (N_B, D_MODEL, D_MODEL), D_MODEL),
        "o_w": nrm(ks[8], (N_B, D_MODEL, D_MODEL), D_MODEL),
        "ffn_in_w": nrm(ks[9], (DEPTH, D_MODEL, 2 * D_FF), D_MODEL),
        "ffn_out_w": nrm(ks[10], (DEPTH, D_FF, D_MODEL), D_FF),
    }


def reference(x, norm_g, conv_in_w, conv_w, conv_out_w, kv_norm_g, kv_w, q_w, o_w,
              ffn_in_w, ffn_out_w):
    slopes = _alibi_slopes()
    shared = None
    for layer in range(DEPTH):
        g = norm_g[layer]
        xn = _rms_norm(x, g[0])
        if layer < N_A:
            mix = _short_conv(xn, conv_in_w[layer], conv_w[layer], conv_out_w[layer])
        else:
            if shared is None:
                shared = _shared_kv(x, kv_norm_g, kv_w)
            j = layer - N_A
            mix = _dilated_attention(xn, q_w[j], o_w[j], shared, slopes)
        x = x + _rms_norm(mix, g[1])
        ff = _swiglu(_rms_norm(x, g[2]), ffn_in_w[layer], ffn_out_w[layer])
        x = x + _rms_norm(ff, g[3])
    return x
```

```cpp
#include <hip/hip_runtime.h>
#include <hip/hip_cooperative_groups.h>
#include <cstdio>
#include <cstdint>
namespace cg = cooperative_groups;

namespace pg8 {
#define PG8_LAS __attribute__((address_space(3)))
typedef unsigned short bf16_t;
typedef short bf16x8 __attribute__((ext_vector_type(8)));
typedef float f32x4 __attribute__((ext_vector_type(4)));
typedef unsigned u32x4 __attribute__((ext_vector_type(4)));
constexpr int BM = 256, BK = 64, HALF = 128, HTB = HALF * BK * 2, STAGE_BYTES = 8 * HTB, NXCD = 8, WGM = 8;

__host__ __device__ __forceinline__ int lds_byte(int r, int c) { const int st = (r >> 4) * 2 + (c >> 5), rr = r & 15, cc = c & 31, ob = rr * 64 + cc * 2; return st * 1024 + (ob ^ (((ob >> 9) & 1) << 5)); }
__host__ __device__ __forceinline__ void stage_rc(int b, int& R, int& C) { const int st = b / 1024, sb = b % 1024, swz = sb ^ (((sb >> 9) & 1) << 5); R = (st >> 1) * 16 + swz / 64; C = (st & 1) * 32 + (swz % 64) / 2; }
__host__ __device__ __forceinline__ int perm32(int rho) { const int n = rho >> 4, i = rho & 15; return 8 * (i >> 2) + 4 * n + (i & 3); }

struct Unit { int pm, pn; };
struct Gemm { const bf16_t* A; const bf16_t* Bt; int M, N, K; };

struct StaticOrder {
    int nM, nN, nwg, G, c;
    __host__ __device__ void init(int M, int N, int G_, int c_) { nM = M / BM; nN = N / BM; nwg = nM * nN; G = G_; c = c_; }
    __host__ __device__ bool next(int i, Unit& u) const { return at(i, u); }
    __host__ __device__ bool at(int i, Unit& u) const {
        const long L = (long)i * G + c; if (L >= nwg) return false;
        int wgid = (int)L; { const int q = nwg / NXCD, r = nwg % NXCD, xcd = wgid % NXCD, off = wgid / NXCD; wgid = (xcd < r ? xcd * (q + 1) : r * (q + 1) + (xcd - r) * q) + off; }
        const int nig = WGM * nN, gid = wgid / nig, fm = gid * WGM, gsz = (nM - fm) < WGM ? (nM - fm) : WGM;
        u.pm = fm + ((wgid % nig) % gsz); u.pn = (wgid % nig) / gsz; return true;
    }
    __device__ __forceinline__ void a_ready(const Unit&) const {}
    __device__ __forceinline__ void done(const Unit&) const {}
};

struct RoundOrder {
    StaticOrder so; int round;
    __device__ __forceinline__ bool next(int i, Unit& u) const { if (i > 0) return false; return so.at(round, u); }
    __device__ __forceinline__ void a_ready(const Unit&) const {}
    __device__ __forceinline__ void done(const Unit&) const {}
};
__device__ __forceinline__ unsigned cvt_pk_bf16(float lo, float hi) { unsigned r; asm volatile("v_cvt_pk_bf16_f32 %0, %1, %2" : "=v"(r) : "v"(lo), "v"(hi)); return r; }

struct EpiBf16 {
    static constexpr bool PERM = true, AFTER_DRAIN = false;
    bf16_t* O; int ldc; int split_cols; size_t split_stride; int hm; bf16_t* O2; int cmul;
    __device__ __forceinline__ void operator()(const f32x4 (&acc)[2][2][4][2], const Unit& u, int wr, int wc, int fr, int fq) const {
        if (cmul && u.pn >= 4) {
            const int row0 = u.pm * BM + wr * 64 + fr, col0 = (u.pn - 4) * HALF + wc * 32 + 8 * fq;
#pragma unroll
            for (int ai = 0; ai < 2; ++ai)
#pragma unroll
                for (int m = 0; m < 4; ++m) { const f32x4 v0 = acc[ai][0][m][0] * acc[ai][1][m][0], v1 = acc[ai][0][m][1] * acc[ai][1][m][1];
                    u32x4 w; w.x = cvt_pk_bf16(v0[0], v0[1]); w.y = cvt_pk_bf16(v0[2], v0[3]); w.z = cvt_pk_bf16(v1[0], v1[1]); w.w = cvt_pk_bf16(v1[2], v1[3]);
                    *(u32x4*)(O2 + (size_t)(row0 + ai * HALF + m * 16) * 1024 + col0) = w; }
            return;
        }
        const int row0 = u.pm * BM + wr * 64 + fr; int colt = u.pn * BM; bf16_t* base = O; int t = 0;
        if (split_cols) { t = colt / split_cols; base += (size_t)t * split_stride; colt -= t * split_cols; }
        const int col0 = colt + wc * 32 + 8 * fq;
        const bool headmajor = hm && t < 2;
#pragma unroll
        for (int ai = 0; ai < 2; ++ai)
#pragma unroll
            for (int m = 0; m < 4; ++m) { const int row = row0 + ai * HALF + m * 16;
                bf16_t* rowp = headmajor ? base + ((size_t)((row >> 13) * 16 + (col0 >> 6)) * 8192 + (row & 8191)) * 64 + (col0 & 63) : base + (size_t)row * ldc + col0;
                const size_t bjstep = headmajor ? (size_t)2 * 8192 * 64 : (size_t)HALF;
#pragma unroll
                for (int bj = 0; bj < 2; ++bj) { const f32x4 v0 = acc[ai][bj][m][0], v1 = acc[ai][bj][m][1];
                    u32x4 w; w.x = cvt_pk_bf16(v0[0], v0[1]); w.y = cvt_pk_bf16(v0[2], v0[3]); w.z = cvt_pk_bf16(v1[0], v1[1]); w.w = cvt_pk_bf16(v1[2], v1[3]);
                    *(u32x4*)(rowp + bj * bjstep) = w; } }
    }
};
__device__ __forceinline__ float silu_mul(float g, float u) { return g * u * __builtin_amdgcn_rcpf(1.0f + __expf(-g)); }
struct EpiSwiGLU {
    static constexpr bool PERM = true, AFTER_DRAIN = false;
    bf16_t* O; int ldc;
    __device__ __forceinline__ void operator()(const f32x4 (&acc)[2][2][4][2], const Unit& u, int wr, int wc, int fr, int fq) const {
        const int row0 = u.pm * BM + wr * 64 + fr; const int col0 = u.pn * HALF + wc * 32 + 8 * fq;
#pragma unroll
        for (int ai = 0; ai < 2; ++ai)
#pragma unroll
            for (int m = 0; m < 4; ++m) { bf16_t* rowp = O + (size_t)(row0 + ai * HALF + m * 16) * ldc + col0;
                const f32x4 g0 = acc[ai][0][m][0], g1 = acc[ai][0][m][1], u0 = acc[ai][1][m][0], u1 = acc[ai][1][m][1];
                u32x4 w; w.x = cvt_pk_bf16(silu_mul(g0[0], u0[0]), silu_mul(g0[1], u0[1])); w.y = cvt_pk_bf16(silu_mul(g0[2], u0[2]), silu_mul(g0[3], u0[3]));
                w.z = cvt_pk_bf16(silu_mul(g1[0], u1[0]), silu_mul(g1[1], u1[1])); w.w = cvt_pk_bf16(silu_mul(g1[2], u1[2]), silu_mul(g1[3], u1[3]));
                *(u32x4*)rowp = w; }
    }
};

struct RmsXchg {
    unsigned long long* xbuf;
    unsigned tag;
    __device__ __forceinline__ void run(const f32x4 (&v)[2][2][4][2], const Unit& u, int wr, int wc, int fr, int fq, PG8_LAS unsigned char* lds, int wid, int lane) const {
        PG8_LAS float* P = (PG8_LAS float*)lds;
        PG8_LAS float* S = (PG8_LAS float*)(lds + 4096);
#pragma unroll
        for (int ai = 0; ai < 2; ++ai)
#pragma unroll
            for (int m = 0; m < 4; ++m) {
                float q = 0.f;
#pragma unroll
                for (int bj = 0; bj < 2; ++bj)
#pragma unroll
                    for (int n = 0; n < 2; ++n) { const f32x4 x = v[ai][bj][m][n]; q += (x[0] * x[0] + x[1] * x[1]) + (x[2] * x[2] + x[3] * x[3]); }
                q += __shfl_xor(q, 16); q += __shfl_xor(q, 32);
                if (fq == 0) P[(ai * HALF + wr * 64 + m * 16 + fr) * 4 + wc] = q;
            }
        asm volatile("s_waitcnt lgkmcnt(0)" ::: "memory"); __builtin_amdgcn_s_barrier(); asm volatile("" ::: "memory");
        const int row = wid * 32 + (lane & 31);
        unsigned long long* slot = xbuf + (size_t)(u.pm * BM + row) * 4;
        if (lane < 32) { const f32x4 p = *(const PG8_LAS f32x4*)(P + row * 4); const float t = (p[0] + p[1]) + (p[2] + p[3]);
            __hip_atomic_store(slot + u.pn, ((unsigned long long)tag << 32) | (unsigned long long)__builtin_bit_cast(unsigned, t), __ATOMIC_RELAXED, __HIP_MEMORY_SCOPE_AGENT); }
        float tot = 0.f; unsigned sp = 0u;
        for (;;) {
            bool ok = true; tot = 0.f;
            if (lane < 32) {
#pragma unroll
                for (int k = 0; k < 4; ++k) { const unsigned long long wv = __hip_atomic_load(slot + k, __ATOMIC_RELAXED, __HIP_MEMORY_SCOPE_AGENT); ok = ok && ((unsigned)(wv >> 32) == tag); tot += __builtin_bit_cast(float, (unsigned)wv); }
            }
            if (__builtin_amdgcn_ballot_w64(!ok) == 0ull) break;
            if (++sp > (1u << 22)) break;
            __builtin_amdgcn_s_sleep(1);
        }
        if (lane < 32) S[row] = 1.0f / sqrtf(tot * (1.0f / 1024.0f) + 1e-6f);
        asm volatile("s_waitcnt lgkmcnt(0)" ::: "memory"); __builtin_amdgcn_s_barrier(); asm volatile("" ::: "memory");
    }
};
struct EpiRmsResRms {
    static constexpr bool PERM = true, AFTER_DRAIN = true;
    const float* base; float* out; bf16_t* xn; const float* gain; const float* inv_in; float* inv_out; RmsXchg st1, st2; int write_xn, write_out;
    __device__ __forceinline__ void fused(f32x4 (&acc)[2][2][4][2], const Unit& u, int wr, int wc, int fr, int fq, PG8_LAS unsigned char* lds, int wid, int lane) const {
        const PG8_LAS float* S = (const PG8_LAS float*)(lds + 4096);
        const int col0 = u.pn * BM + wc * 32 + 8 * fq;
        u32x4 pre[4][2]; float ivs[4], ivs1[4];
        if (!base) {
#pragma unroll
            for (int m = 0; m < 4; ++m) { const int r = wr * 64 + m * 16 + fr; const size_t off = (size_t)(u.pm * BM + r) * 1024 + col0; ivs[m] = inv_in[u.pm * BM + r]; ivs1[m] = inv_in[u.pm * BM + HALF + r];
#pragma unroll
                for (int bj = 0; bj < 2; ++bj) pre[m][bj] = *(const u32x4*)(xn + off + bj * HALF); }
        }
        f32x4 gq[2][2];
#pragma unroll
        for (int bj = 0; bj < 2; ++bj) { gq[bj][0] = *(const f32x4*)(gain + col0 + bj * HALF); gq[bj][1] = *(const f32x4*)(gain + col0 + bj * HALF + 4); }
        st1.run(acc, u, wr, wc, fr, fq, lds, wid, lane);
#pragma unroll
        for (int ai = 0; ai < 2; ++ai)
#pragma unroll
            for (int m = 0; m < 4; ++m) { const int r = ai * HALF + wr * 64 + m * 16 + fr; const float rs = S[r]; const size_t off = (size_t)(u.pm * BM + r) * 1024 + col0;
#pragma unroll
                for (int bj = 0; bj < 2; ++bj) { f32x4 b0, b1;
                    if (base) { b0 = *(const f32x4*)(base + off + bj * HALF); b1 = *(const f32x4*)(base + off + bj * HALF + 4); }
                    else { const u32x4 w = (ai == 0) ? pre[m][bj] : *(const u32x4*)(xn + off + bj * HALF); const float iv = (ai == 0) ? ivs[m] : ivs1[m];
                        b0 = (f32x4){__builtin_bit_cast(float, w.x << 16), __builtin_bit_cast(float, w.x & 0xffff0000u), __builtin_bit_cast(float, w.y << 16), __builtin_bit_cast(float, w.y & 0xffff0000u)} * iv;
                        b1 = (f32x4){__builtin_bit_cast(float, w.z << 16), __builtin_bit_cast(float, w.z & 0xffff0000u), __builtin_bit_cast(float, w.w << 16), __builtin_bit_cast(float, w.w & 0xffff0000u)} * iv; }
                    acc[ai][bj][m][0] = b0 + acc[ai][bj][m][0] * rs * gq[bj][0]; acc[ai][bj][m][1] = b1 + acc[ai][bj][m][1] * rs * gq[bj][1]; }
                asm volatile("" : "+v"(acc[ai][0][m][0]), "+v"(acc[ai][0][m][1]), "+v"(acc[ai][1][m][0]), "+v"(acc[ai][1][m][1]));
                if (m & 1) asm volatile("" ::: "memory"); }
        if (write_xn) st2.run(acc, u, wr, wc, fr, fq, lds, wid, lane);
#pragma unroll
        for (int ai = 0; ai < 2; ++ai)
#pragma unroll
            for (int m = 0; m < 4; ++m) { const int r = ai * HALF + wr * 64 + m * 16 + fr; const float rs = S[r]; const size_t off = (size_t)(u.pm * BM + r) * 1024 + col0;
#pragma unroll
                for (int bj = 0; bj < 2; ++bj) { const f32x4 x0 = acc[ai][bj][m][0], x1 = acc[ai][bj][m][1];
                    if (write_out) { *(f32x4*)(out + off + bj * HALF) = x0; *(f32x4*)(out + off + bj * HALF + 4) = x1; }
                    if (write_xn) { const f32x4 o0 = x0 * rs, o1 = x1 * rs; u32x4 w; w.x = cvt_pk_bf16(o0[0], o0[1]); w.y = cvt_pk_bf16(o0[2], o0[3]); w.z = cvt_pk_bf16(o1[0], o1[1]); w.w = cvt_pk_bf16(o1[2], o1[3]);
                        *(u32x4*)(xn + off + bj * HALF) = w; } }
                asm volatile("" ::: "memory"); }
        if (write_xn && u.pn == 0 && lane < 32) inv_out[u.pm * BM + wid * 32 + lane] = 1.0f / S[wid * 32 + lane];
    }
};

template <class Epi, class Sched, bool ALIGN_EPI = false, bool SP2 = false>
__device__ __forceinline__ void gemm_phase(PG8_LAS unsigned char* lds, const Gemm g, const Sched& S, const Epi& E) {
    int tid = threadIdx.x; asm volatile("" : "+v"(tid));
    const int wid = __builtin_amdgcn_readfirstlane(tid >> 6), lane = tid & 63, wr = wid >> 2, wc = wid & 3, fr = lane & 15, fq = lane >> 4;
    const int K = g.K, nt = K / BK;
    unsigned voffA[2], voffB[2];
#pragma unroll
    for (int i = 0; i < 2; ++i) { int R, C; stage_rc(tid * 16 + i * 8192, R, C); const int Rb = Epi::PERM ? ((R & ~31) + perm32(R & 31)) : R;
        voffA[i] = (unsigned)(R * K + C) * 2u; voffB[i] = (unsigned)(Rb * K + C) * 2u; }
    const size_t kstep = (size_t)(BK * 2);
    const size_t hstep = (size_t)HALF * K * 2;
    const size_t tstep = 2 * hstep;
    const unsigned ldsw = (unsigned)wid * 1024u;
    const int aoff = lds_byte(wr * 64 + fr, fq * 8), boff = lds_byte(wc * 32 + fr, fq * 8);
#define PG8_SA(b, h) (((b) * 2 + (h)) * HTB)
#define PG8_SB(b, h) ((4 + (b) * 2 + (h)) * HTB)
#define PG8_STAGE(bufoff, gbase, voff) do { _Pragma("unroll") for (int _i = 0; _i < 2; ++_i) \
        __builtin_amdgcn_global_load_lds((const unsigned*)((const char*)(gbase) + (voff)[_i]), (PG8_LAS unsigned*)(lds + (bufoff) + ldsw + _i * 8192), 16, 0, 0); } while (0)
#define PG8_LDA(dst, b, h) do { _Pragma("unroll") for (int m = 0; m < 4; ++m) _Pragma("unroll") for (int k = 0; k < 2; ++k) dst[m][k] = *(const PG8_LAS bf16x8*)(lds + PG8_SA(b, h) + aoff + m * 2048 + k * 1024); } while (0)
#define PG8_LDB(dst, b, h) do { _Pragma("unroll") for (int n = 0; n < 2; ++n) _Pragma("unroll") for (int k = 0; k < 2; ++k) dst[n][k] = *(const PG8_LAS bf16x8*)(lds + PG8_SB(b, h) + boff + n * 2048 + k * 1024); } while (0)
#define PG8_MMA(ai, bj, At, Bt) do { __builtin_amdgcn_s_setprio(1); _Pragma("unroll") for (int m = 0; m < 4; ++m) _Pragma("unroll") for (int n = 0; n < 2; ++n) _Pragma("unroll") for (int k = 0; k < 2; ++k) \
        acc[ai][bj][m][n] = __builtin_amdgcn_mfma_f32_16x16x32_bf16(Bt[n][k], At[m][k], acc[ai][bj][m][n], 0, 0, 0); __builtin_amdgcn_s_setprio(0); } while (0)
#define PG8_WAIT_V(n) asm volatile("s_waitcnt vmcnt(" #n ")" ::: "memory")
#define PG8_WAIT_L(n) asm volatile("s_waitcnt lgkmcnt(" #n ")" ::: "memory")
#define PG8_BAR __builtin_amdgcn_s_barrier()
#define PG8_SCHED __builtin_amdgcn_sched_barrier(0)
    Unit cur, nxt; int ui = 0;
    if (!S.next(0, cur)) return;
    f32x4 acc[2][2][4][2];
#pragma unroll
    for (int a = 0; a < 2; ++a)
#pragma unroll
        for (int b = 0; b < 2; ++b)
#pragma unroll
            for (int m = 0; m < 4; ++m)
#pragma unroll
                for (int n = 0; n < 2; ++n) acc[a][b][m][n] = (f32x4){0.f, 0.f, 0.f, 0.f};
    bf16x8 At[4][2], B0[2][2], B1[2][2];
    const char* cA = (const char*)g.A + (size_t)cur.pm * tstep; const char* cB = (const char*)g.Bt + (size_t)cur.pn * tstep;
    S.a_ready(cur);
    if constexpr (SP2) {
        PG8_STAGE(PG8_SB(0, 0), cB, voffB); PG8_STAGE(PG8_SB(0, 1), cB + hstep, voffB); PG8_STAGE(PG8_SA(0, 0), cA, voffA); PG8_STAGE(PG8_SA(0, 1), cA + hstep, voffA);
        if (wr == 1) PG8_BAR;
        PG8_WAIT_V(2); PG8_BAR;
        PG8_STAGE(PG8_SB(1, 0), cB + kstep, voffB); PG8_STAGE(PG8_SA(1, 0), cA + kstep, voffA); PG8_STAGE(PG8_SB(1, 1), cB + hstep + kstep, voffB);
        PG8_WAIT_V(6); PG8_BAR;
    } else {
        PG8_STAGE(PG8_SB(0, 0), cB, voffB); PG8_STAGE(PG8_SA(0, 0), cA, voffA); PG8_STAGE(PG8_SB(0, 1), cB + hstep, voffB); PG8_STAGE(PG8_SA(0, 1), cA + hstep, voffA);
        if (wr == 1) PG8_BAR;
        PG8_WAIT_V(4); PG8_BAR;
        PG8_STAGE(PG8_SB(1, 0), cB + kstep, voffB); PG8_STAGE(PG8_SA(1, 0), cA + kstep, voffA); PG8_STAGE(PG8_SB(1, 1), cB + hstep + kstep, voffB);
        PG8_WAIT_V(6); PG8_BAR;
    }
    for (;;) {
        const bool has_next = S.next(ui + 1, nxt);
        const char* nA = has_next ? (const char*)g.A + (size_t)nxt.pm * tstep : cA; const char* nB = has_next ? (const char*)g.Bt + (size_t)nxt.pn * tstep : cB;
        for (int t = 0; t < nt; t += 2) {
            const bool last = (t == nt - 2);
            const char* a1 = cA + (size_t)(t + 1) * kstep;
            const char* a2 = last ? nA : cA + (size_t)(t + 2) * kstep; const char* b2 = last ? nB : cB + (size_t)(t + 2) * kstep;
            const char* a3 = a2 + kstep; const char* b3 = b2 + kstep;
            if (last && has_next) S.a_ready(nxt);
            if constexpr (SP2) {
            PG8_LDB(B0, 0, 0); PG8_LDB(B1, 0, 1); PG8_SCHED; PG8_LDA(At, 0, 0); PG8_STAGE(PG8_SA(1, 1), a1 + hstep, voffA);
            PG8_WAIT_V(8); PG8_WAIT_L(0); PG8_BAR; PG8_MMA(0, 0, At, B0); PG8_MMA(0, 1, At, B1); PG8_BAR; PG8_SCHED;
            PG8_LDA(At, 0, 1); PG8_STAGE(PG8_SB(0, 0), b2, voffB); PG8_STAGE(PG8_SB(0, 1), b2 + hstep, voffB); PG8_STAGE(PG8_SA(0, 0), a2, voffA);
            PG8_WAIT_V(8); PG8_WAIT_L(0); PG8_BAR; PG8_MMA(1, 0, At, B0); PG8_MMA(1, 1, At, B1); PG8_BAR; PG8_SCHED;
            PG8_LDB(B0, 1, 0); PG8_LDB(B1, 1, 1); PG8_SCHED; PG8_LDA(At, 1, 0); PG8_STAGE(PG8_SA(0, 1), a2 + hstep, voffA);
            PG8_WAIT_V(8); PG8_WAIT_L(0); PG8_BAR; PG8_MMA(0, 0, At, B0); PG8_MMA(0, 1, At, B1); PG8_BAR; PG8_SCHED;
            PG8_LDA(At, 1, 1); PG8_STAGE(PG8_SB(1, 0), b3, voffB); PG8_STAGE(PG8_SB(1, 1), b3 + hstep, voffB); PG8_STAGE(PG8_SA(1, 0), a3, voffA);
            PG8_WAIT_V(8); PG8_WAIT_L(0); PG8_BAR; PG8_MMA(1, 0, At, B0); PG8_MMA(1, 1, At, B1); PG8_BAR; PG8_SCHED;
            } else {
            PG8_LDB(B0, 0, 0); PG8_SCHED; PG8_LDA(At, 0, 0); PG8_STAGE(PG8_SA(1, 1), a1 + hstep, voffA);
            PG8_WAIT_L(8); PG8_BAR; PG8_WAIT_L(0); PG8_MMA(0, 0, At, B0); PG8_BAR; PG8_SCHED;
            PG8_LDB(B1, 0, 1); PG8_STAGE(PG8_SB(0, 0), b2, voffB);
            PG8_BAR; PG8_WAIT_L(0); PG8_MMA(0, 1, At, B1); PG8_BAR;
            PG8_LDA(At, 0, 1); PG8_STAGE(PG8_SA(0, 0), a2, voffA);
            PG8_BAR; PG8_WAIT_L(0); PG8_MMA(1, 0, At, B0); PG8_BAR; PG8_SCHED;
            PG8_STAGE(PG8_SB(0, 1), b2 + hstep, voffB);
            PG8_WAIT_V(6); PG8_BAR; PG8_MMA(1, 1, At, B1); PG8_BAR;
            PG8_LDB(B0, 1, 0); PG8_SCHED; PG8_LDA(At, 1, 0); PG8_STAGE(PG8_SA(0, 1), a2 + hstep, voffA);
            PG8_WAIT_L(8); PG8_BAR; PG8_WAIT_L(0); PG8_MMA(0, 0, At, B0); PG8_BAR; PG8_SCHED;
            PG8_LDB(B1, 1, 1); PG8_STAGE(PG8_SB(1, 0), b3, voffB);
            PG8_BAR; PG8_WAIT_L(0); PG8_MMA(0, 1, At, B1); PG8_BAR;
            PG8_LDA(At, 1, 1); PG8_STAGE(PG8_SA(1, 0), a3, voffA);
            PG8_BAR; PG8_WAIT_L(0); PG8_MMA(1, 0, At, B0); PG8_BAR; PG8_SCHED;
            PG8_STAGE(PG8_SB(1, 1), b3 + hstep, voffB);
            PG8_WAIT_V(6); PG8_BAR; PG8_MMA(1, 1, At, B1); PG8_BAR;
            }
        }
        if constexpr (ALIGN_EPI) { if (wr == 0) PG8_BAR; }
        if constexpr (!Epi::AFTER_DRAIN) { E(acc, cur, wr, wc, fr, fq); S.done(cur); }
        if (!has_next) break;
#pragma unroll
        for (int a = 0; a < 2; ++a)
#pragma unroll
            for (int b = 0; b < 2; ++b)
#pragma unroll
                for (int m = 0; m < 4; ++m)
#pragma unroll
                    for (int n = 0; n < 2; ++n) acc[a][b][m][n] = (f32x4){0.f, 0.f, 0.f, 0.f};
        cur = nxt; cA = nA; cB = nB; ++ui;
        if constexpr (ALIGN_EPI) { if (wr == 1) PG8_BAR; }
    }
    PG8_WAIT_V(0);
    if constexpr (!ALIGN_EPI) { if (wr == 0) PG8_BAR; }
    PG8_BAR;
    if constexpr (Epi::AFTER_DRAIN) { E.fused(acc, cur, wr, wc, fr, fq, lds, wid, lane); S.done(cur); }
#undef PG8_SA
#undef PG8_SB
#undef PG8_STAGE
#undef PG8_LDA
#undef PG8_LDB
#undef PG8_MMA
#undef PG8_WAIT_V
#undef PG8_WAIT_L
#undef PG8_BAR
#undef PG8_SCHED
}
}

#define LAS __attribute__((address_space(3)))
typedef unsigned short bf16;
typedef unsigned v4u __attribute__((ext_vector_type(4)));
typedef unsigned v2u __attribute__((ext_vector_type(2)));
typedef float f32x4 __attribute__((ext_vector_type(4)));
constexpr int NWAVES = 8, NT = 512;
constexpr int BATCH = 4, SEQ = 8192, D = 1024, M = BATCH * SEQ, NH = 16, HD = 64, FF = 2816, DEPTH = 4;
constexpr float EPS = 1e-6f;
constexpr size_t MiB = 1u << 20;
constexpr size_t WS_CTL = 0, WS_LSE = 1 * MiB, WS_W0 = 4 * MiB, WS_W1 = 29 * MiB, WS_XN = 54 * MiB, WS_G = 118 * MiB, WS_KV = 182 * MiB, WS_H = 310 * MiB, WS_XB = 486 * MiB, WS_INV = 490 * MiB, WS_END = 491 * MiB;
constexpr int CW_SEAM = 16384, SEAM_BANK = 128 * 64;
constexpr size_t WO_1 = 0, WO_3 = 6 * MiB, WO_FI = 8 * MiB, WO_FO = 19 * MiB;
constexpr int LDS_BYTES = 131072 + 1024;

struct Args { const float* in[11]; float* out; unsigned char* ws; };

__device__ __forceinline__ unsigned f2bf(float f) { unsigned u = __builtin_bit_cast(unsigned, f); return (u + 0x7fffu + ((u >> 16) & 1u)) >> 16; }
__device__ __forceinline__ unsigned pk2(float lo, float hi) { return pg8::cvt_pk_bf16(lo, hi); }
__device__ __forceinline__ float bflo(unsigned w) { return __builtin_bit_cast(float, w << 16); }
__device__ __forceinline__ float bfhi(unsigned w) { return __builtin_bit_cast(float, w & 0xffff0000u); }
__device__ __forceinline__ float wave_sum(float v) {
#pragma unroll
    for (int o = 1; o < 64; o <<= 1) v += __shfl_xor(v, o);
    return v;
}
__device__ __forceinline__ float wave_max(float v) {
#pragma unroll
    for (int o = 1; o < 64; o <<= 1) v = fmaxf(v, __shfl_xor(v, o));
    return v;
}
#define LDS_WAIT() asm volatile("s_waitcnt lgkmcnt(0)" ::: "memory")
template <class T> __device__ __forceinline__ T* opq(T* p) { size_t z = 0; asm volatile("" : "+s"(z)); return (T*)((unsigned char*)p + z); }
__device__ __forceinline__ int opqv(int v) { asm volatile("" : "+v"(v)); return v; }

__device__ __forceinline__ void tr_item(const float* W, int K, int N, const float* gain, float scale, bf16* WT, int swiglu, int row_off, LAS float* scr, int item, int lane) {
    const int nblk = N / 32, kb = item / nblk, nb = item % nblk, k0 = 64 * kb, n0 = 32 * nb;
    {
        const int kq = lane >> 3, n4 = (lane & 7) * 4;
        f32x4 wv[8];
#pragma unroll
        for (int i = 0; i < 8; ++i) wv[i] = *(const f32x4*)(W + (size_t)(k0 + 8 * i + kq) * N + n0 + n4);
#pragma unroll
        for (int i = 0; i < 8; ++i) { const int kk = 8 * i + kq; const float gk = gain ? gain[k0 + kk] * scale : scale;
            scr[kk * 33 + n4 + 0] = wv[i][0] * gk; scr[kk * 33 + n4 + 1] = wv[i][1] * gk; scr[kk * 33 + n4 + 2] = wv[i][2] * gk; scr[kk * 33 + n4 + 3] = wv[i][3] * gk; }
    }
    LDS_WAIT(); asm volatile("" ::: "memory");
    int drow0 = n0;
    if (swiglu == 1) drow0 = (n0 < FF) ? ((n0 >> 7) * 256 + (n0 & 127)) : (((n0 - FF) >> 7) * 256 + 128 + ((n0 - FF) & 127));
    if (swiglu == 2) drow0 = (n0 < D) ? n0 : ((n0 < 2 * D) ? (D + ((n0 - D) >> 7) * 256 + ((n0 - D) & 127)) : (D + ((n0 - 2 * D) >> 7) * 256 + 128 + ((n0 - 2 * D) & 127)));
    drow0 += row_off;
    const int c = lane & 7;
#pragma unroll
    for (int j = 0; j < 4; ++j) { const int n = (lane >> 3) + 8 * j; const LAS float* s = scr + (8 * c) * 33 + n;
        v4u o; o.x = pk2(s[0 * 33], s[1 * 33]); o.y = pk2(s[2 * 33], s[3 * 33]); o.z = pk2(s[4 * 33], s[5 * 33]); o.w = pk2(s[6 * 33], s[7 * 33]);
        *(v4u*)(WT + (size_t)(drow0 + n) * K + k0 + 8 * c) = o; }
    LDS_WAIT(); asm volatile("" ::: "memory");
}
__device__ __forceinline__ void convert_layer(const Args& a, int l, unsigned char* wbuf, LAS float* scr, int gw, int NGW, int lane) {
    const float* ng = a.in[1] + (size_t)l * 4 * D;
    bf16* W1 = (bf16*)(wbuf + WO_1); bf16* W3 = (bf16*)(wbuf + WO_3); bf16* WFI = (bf16*)(wbuf + WO_FI); bf16* WFO = (bf16*)(wbuf + WO_FO);
    const int n0 = (l < 2) ? 1536 : (l == 2 ? 1024 : 0), n1 = (l < 2) ? 0 : 512, n2 = 512, n3 = 2816, n4 = 1408;
    const int total = n0 + n1 + n2 + n3 + n4;
    for (int it = gw; it < total; it += NGW) {
        int r = it;
        if (r < n0) { if (l < 2) tr_item(a.in[2] + (size_t)l * D * 3 * D, D, 3 * D, ng, 1.f, W1, 2, 0, scr, r, lane);
                      else tr_item(a.in[6], D, 2 * D, a.in[5], 1.f, W1, 0, 0, scr, r, lane); continue; } r -= n0;
        if (r < n1) { tr_item(a.in[7] + (size_t)(l - 2) * D * D, D, D, ng, 0.125f * 1.4426950408889634f, W1, 0, (l == 2) ? 2 * D : 0, scr, r, lane); continue; } r -= n1;
        if (r < n2) { tr_item((l < 2) ? a.in[4] + (size_t)l * D * D : a.in[8] + (size_t)(l - 2) * D * D, D, D, nullptr, 1.f, W3, 0, 0, scr, r, lane); continue; } r -= n2;
        if (r < n3) { tr_item(a.in[9] + (size_t)l * D * 2 * FF, D, 2 * FF, ng + 2 * D, 1.f, WFI, 1, 0, scr, r, lane); continue; } r -= n3;
        tr_item(a.in[10] + (size_t)l * FF * D, FF, D, nullptr, 1.f, WFO, 0, 0, scr, r, lane);
    }
}
__device__ __forceinline__ void unpack8(const v4u w, float (&f)[8]) { f[0] = bflo(w.x); f[1] = bfhi(w.x); f[2] = bflo(w.y); f[3] = bfhi(w.y); f[4] = bflo(w.z); f[5] = bfhi(w.z); f[6] = bflo(w.w); f[7] = bfhi(w.w); }
__device__ __forceinline__ void conv_phase(const bf16* Bg, const bf16* U, const float* wconv, bf16* Aout, int bid, int G, int tid) {
    const int cgp = tid & 127, rc = tid >> 7, c0 = cgp * 8;
    float w0[8], w1[8], w2[8];
#pragma unroll
    for (int e = 0; e < 8; ++e) { w0[e] = wconv[c0 + e]; w1[e] = wconv[D + c0 + e]; w2[e] = wconv[2 * D + c0 + e]; }
    for (int it = bid; it < M / 128; it += G) {
        const int row0 = it * 128 + rc * 32;
        float um2[8], um1[8];
        if ((row0 & (SEQ - 1)) == 0) {
#pragma unroll
            for (int e = 0; e < 8; ++e) { um2[e] = 0.f; um1[e] = 0.f; }
        } else { unpack8(*(const v4u*)(U + (size_t)(row0 - 2) * D + c0), um2); unpack8(*(const v4u*)(U + (size_t)(row0 - 1) * D + c0), um1); }
#pragma unroll 4
        for (int r = 0; r < 32; ++r) {
            float b[8], u[8], o[8];
            unpack8(*(const v4u*)(Bg + (size_t)(row0 + r) * D + c0), b); unpack8(*(const v4u*)(U + (size_t)(row0 + r) * D + c0), u);
#pragma unroll
            for (int e = 0; e < 8; ++e) { o[e] = b[e] * (w0[e] * um2[e] + w1[e] * um1[e] + w2[e] * u[e]); um2[e] = um1[e]; um1[e] = u[e]; }
            v4u w; w.x = pk2(o[0], o[1]); w.y = pk2(o[2], o[3]); w.z = pk2(o[4], o[5]); w.w = pk2(o[6], o[7]);
            *(v4u*)(Aout + (size_t)(row0 + r) * D + c0) = w;
        }
    }
}
typedef short bf16x8 __attribute__((ext_vector_type(8)));
typedef short s16x4 __attribute__((ext_vector_type(4)));
constexpr int KSTR = 144, VSTR = 160, LDS_KOFF = 0, LDS_VOFF = 256 * KSTR, LDS_OSC = 81920;
__device__ __forceinline__ s16x4 vtr(const LAS unsigned char* p) { return __builtin_amdgcn_ds_read_tr16_b64_v4i16((LAS s16x4*)p); }
struct AttBlk { int dl, r, n, g; };
__device__ __forceinline__ AttBlk att_decode(int bi, int sp) { AttBlk k; k.g = bi >> 4; const int j = bi & 15; k.dl = 1 << (2 * k.g);
    k.r = (k.g == 0) ? 0 : (k.g == 1 ? (j >> 2) : j); k.n = (k.g == 0) ? 16 * sp + j : (k.g == 1 ? 4 * sp + (j & 3) : sp); return k; }
__device__ __forceinline__ void att_prefetch(const bf16* Q, const bf16* K, const bf16* V, size_t headoff, int b, int h, int sp, int bi, int skk, int spart, int w, int fr, int fq,
                                             v4u (&pk)[4], v4u (&pv)[4], bf16x8& q0, bf16x8& q1, const bf16* O, const float* LSE, v4u (&op)[2], float& lp) {
    const AttBlk k = att_decode(bi, sp);
    const unsigned char* Kb = (const unsigned char*)(K + headoff); const unsigned char* Vb = (const unsigned char*)(V + headoff);
    const int tok0 = ((k.n - 1) * 128) * k.dl + k.r;
#pragma unroll
    for (int i = 0; i < 4; ++i) { const int kk = skk + 64 * i; int tok = tok0 + kk * k.dl; tok = tok < 0 ? 0 : tok;
        const unsigned off = (unsigned)tok * (HD * 2) + (unsigned)spart * 16u; pk[i] = *(const v4u*)(Kb + off); pv[i] = *(const v4u*)(Vb + off); }
    const unsigned char* Qb = (const unsigned char*)(Q + (size_t)b * SEQ * D + h * HD); const unsigned char* Ob = (const unsigned char*)(O + (size_t)b * SEQ * D + h * HD);
    const float* Lb = LSE + (size_t)(b * NH + h) * SEQ;
    const int t0 = (128 * k.n + 16 * w) * k.dl + k.r;
    const unsigned qt = (unsigned)(t0 + fr * k.dl);
    const unsigned qoff = qt * (D * 2) + (unsigned)fq * 16u;
    q0 = *(const bf16x8*)(Qb + qoff); q1 = *(const bf16x8*)(Qb + qoff + 64);
    lp = Lb[qt];
    const int lane_ = fr + 16 * fq;
#pragma unroll
    for (int i = 0; i < 2; ++i) { const unsigned ot = (unsigned)(t0 + ((lane_ >> 3) + 8 * i) * k.dl); op[i] = *(const v4u*)(Ob + ot * (D * 2) + (unsigned)(lane_ & 7) * 16u); }
}
template <int MODE> __device__ __forceinline__ void att_block(const bf16* Q, const bf16* K, const bf16* V, bf16* O, float* LSE, LAS unsigned char* lds, size_t headoff, float slope2, int b, int h, int sp, int bi,
                                          int skk, int spart, int w, int fr, int fq, v4u (&pk)[4], v4u (&pv)[4], bf16x8& qa, bf16x8& qb, v4u (&opn)[2], float& lpn) {
    const AttBlk k = att_decode(bi, sp);
    const int dl = k.dl, r = k.r, n = k.n, g = k.g;
    asm volatile("s_waitcnt vmcnt(12)" ::: "memory");
    __syncthreads();
    const int uq = 16 * w + fr;
    const size_t qrow = (size_t)b * SEQ + (size_t)(128 * n + uq) * dl + r;
    float lse_prev = lpn; unsigned long long oprev[4];
    LAS unsigned char* osc = lds + LDS_OSC + w * 2304;
    const int lane_ = fr + 16 * fq;
#pragma unroll
    for (int i = 0; i < 2; ++i) *(LAS v4u*)(osc + ((lane_ >> 3) + 8 * i) * 144 + (lane_ & 7) * 16) = opn[i];
#pragma unroll
    for (int dt = 0; dt < 4; ++dt) oprev[dt] = *(const LAS unsigned long long*)(osc + fr * 144 + 32 * dt + 8 * fq);
#pragma unroll
    for (int i = 0; i < 4; ++i) { const int kk = skk + 64 * i; const bool z = (n == 0) && (i < 2);
        const v4u kz = z ? (v4u){0u, 0u, 0u, 0u} : pk[i], vz = z ? (v4u){0u, 0u, 0u, 0u} : pv[i];
        *(LAS v4u*)(lds + LDS_KOFF + kk * KSTR + spart * 16) = kz; *(LAS v4u*)(lds + LDS_VOFF + kk * VSTR + spart * 16) = vz; }
    const bf16x8 q0 = qa, q1 = qb;
    __syncthreads();
    att_prefetch(Q, K, V, headoff, b, h, sp, (bi + 2 < 48) ? bi + 2 : 47, skk, spart, w, fr, fq, pk, pv, qa, qb, O, LSE, opn, lpn);
    float l_run = 0.f; f32x4 oacc[4]; float m_run = 0.f;
#pragma unroll
    for (int dt = 0; dt < 4; ++dt) oacc[dt] = (f32x4){0.f, 0.f, 0.f, 0.f};
    if (MODE & 1) {
    const float bsl = slope2 * (float)dl;
    const float c0 = -bsl * (float)(fr + 128 - 4 * fq); const f32x4 B0 = (f32x4){c0, c0 + bsl, c0 + 2.f * bsl, c0 + 3.f * bsl};
    f32x4 sv[9];
    {
        const LAS unsigned char* kbase = lds + LDS_KOFF + (16 * w + fr) * KSTR + 16 * fq;
        bf16x8 kf[3][2];
#pragma unroll
        for (int bt = 0; bt < 3; ++bt) {
#pragma unroll
            for (int t = 0; t < 3; ++t) { kf[t][0] = *(const LAS bf16x8*)(kbase + (16 * (3 * bt + t)) * KSTR); kf[t][1] = *(const LAS bf16x8*)(kbase + (16 * (3 * bt + t)) * KSTR + 64); }
            __builtin_amdgcn_sched_barrier(0);
#pragma unroll
            for (int t = 0; t < 3; ++t) { f32x4 acc0 = B0;
                acc0 = __builtin_amdgcn_mfma_f32_16x16x32_bf16(kf[t][0], q0, acc0, 0, 0, 0); acc0 = __builtin_amdgcn_mfma_f32_16x16x32_bf16(kf[t][1], q1, acc0, 0, 0, 0);
                sv[3 * bt + t] = acc0; }
            __builtin_amdgcn_sched_barrier(0);
        }
    }
#pragma unroll
    for (int v = 0; v < 4; ++v) { if (4 * fq + v < fr) sv[0][v] = -INFINITY; if (4 * fq + v > fr) sv[8][v] = -INFINITY; }
    float tj[9];
#pragma unroll
    for (int jj = 0; jj < 9; ++jj) tj[jj] = (n == 0 && w + jj < 8) ? -INFINITY : bsl * (float)(16 * jj);
    float mloc = -INFINITY;
#pragma unroll
    for (int jj = 0; jj < 9; ++jj) mloc = fmaxf(mloc, fmaxf(fmaxf(sv[jj][0], sv[jj][1]), fmaxf(sv[jj][2], sv[jj][3])) + tj[jj]);
    mloc = fmaxf(mloc, __shfl_xor(mloc, 16)); mloc = fmaxf(mloc, __shfl_xor(mloc, 32));
    m_run = mloc;
    unsigned pw[10][2];
#pragma unroll
    for (int jj = 0; jj < 9; ++jj) { float pe[4]; const float dj = tj[jj] - mloc;
#pragma unroll
        for (int v = 0; v < 4; ++v) { pe[v] = __builtin_amdgcn_exp2f(sv[jj][v] + dj); l_run += pe[v]; }
        pw[jj][0] = pg8::cvt_pk_bf16(pe[0], pe[1]); pw[jj][1] = pg8::cvt_pk_bf16(pe[2], pe[3]); }
    pw[9][0] = 0u; pw[9][1] = 0u;
    {
        const LAS unsigned char* vbase = lds + LDS_VOFF + (16 * w + 4 * fq + (fr >> 2)) * VSTR + (4 * (fr & 3)) * 2;
        s16x4 vf[4][2], vn[4][2];
#pragma unroll
        for (int dt = 0; dt < 4; ++dt) { vf[dt][0] = vtr(vbase + 32 * dt); vf[dt][1] = vtr(vbase + 32 * dt + 16 * VSTR); }
#pragma unroll
        for (int pp = 0; pp < 5; ++pp) {
            if (pp < 4) {
#pragma unroll
                for (int dt = 0; dt < 4; ++dt) { vn[dt][0] = vtr(vbase + 32 * (pp + 1) * VSTR + 32 * dt); vn[dt][1] = vtr(vbase + 32 * (pp + 1) * VSTR + 32 * dt + 16 * VSTR); }
            }
            __builtin_amdgcn_sched_barrier(0);
            const v4u pq = (v4u){pw[2 * pp][0], pw[2 * pp][1], pw[2 * pp + 1][0], pw[2 * pp + 1][1]};
            const bf16x8 pfrag = __builtin_bit_cast(bf16x8, pq);
#pragma unroll
            for (int dt = 0; dt < 4; ++dt) {
                const bf16x8 af = (bf16x8){vf[dt][0][0], vf[dt][0][1], vf[dt][0][2], vf[dt][0][3], vf[dt][1][0], vf[dt][1][1], vf[dt][1][2], vf[dt][1][3]};
                oacc[dt] = __builtin_amdgcn_mfma_f32_16x16x32_bf16(af, pfrag, oacc[dt], 0, 0, 0);
            }
            __builtin_amdgcn_sched_barrier(0);
            if (pp < 4) {
#pragma unroll
                for (int dt = 0; dt < 4; ++dt) { vf[dt][0] = vn[dt][0]; vf[dt][1] = vn[dt][1]; }
            }
        }
    }
    } else { l_run = 1.f; }
    float l = l_run; l += __shfl_xor(l, 16); l += __shfl_xor(l, 32);
    if (g == 0) { lse_prev = -INFINITY; oprev[0] = 0ull; oprev[1] = 0ull; oprev[2] = 0ull; oprev[3] = 0ull; }
    const float m_tot = fmaxf(lse_prev, m_run), wp = __builtin_amdgcn_exp2f(lse_prev - m_tot), wcur = __builtin_amdgcn_exp2f(m_run - m_tot);
    const float denom = wp + l * wcur, inv = __builtin_amdgcn_rcpf(denom), cp = wp * inv, cc = wcur * inv;
#pragma unroll
    for (int dt = 0; dt < 4; ++dt) { const unsigned lo = (unsigned)oprev[dt], hi = (unsigned)(oprev[dt] >> 32); const f32x4 op = (f32x4){bflo(lo), bfhi(lo), bflo(hi), bfhi(hi)};
        const f32x4 o = op * cp + oacc[dt] * cc; v2u ov; ov.x = pg8::cvt_pk_bf16(o[0], o[1]); ov.y = pg8::cvt_pk_bf16(o[2], o[3]);
        *(LAS v2u*)(osc + fr * 144 + 32 * dt + 8 * fq) = ov; }
#pragma unroll
    for (int i = 0; i < 2; ++i) { const v4u rowv = *(const LAS v4u*)(osc + ((lane_ >> 3) + 8 * i) * 144 + (lane_ & 7) * 16);
        const size_t orow = (size_t)b * SEQ + (size_t)(128 * n + 16 * w + (lane_ >> 3) + 8 * i) * dl + r; *(v4u*)(O + orow * D + h * HD + (lane_ & 7) * 8) = rowv; }
    if (fq == 0) LSE[(size_t)(b * NH + h) * SEQ + (qrow - (size_t)b * SEQ)] = m_tot + __builtin_amdgcn_logf(denom);
}
template <int MODE> __device__ __forceinline__ void attn_fast(const bf16* Q, const bf16* K, const bf16* V, bf16* O, float* LSE, LAS unsigned char* lds, int bid, int G, int tid) {
    const int lane = tid & 63, w = __builtin_amdgcn_readfirstlane(tid >> 6), fr = lane & 15, fq = lane >> 4;
    for (int i = tid; i < 16 * VSTR / 4; i += NT) ((LAS unsigned*)(lds + LDS_VOFF + 256 * VSTR))[i] = 0u;
    const int skk = tid >> 3, spart = tid & 7;
    for (int uid_ = bid; uid_ < 256; uid_ += G) { const int uid = (((uid_ & 7) << 5) | ((uid_ & 255) >> 3));
        const int b = uid >> 6, h = (uid >> 2) & 15, sp = uid & 3;
        const float slope2 = exp2f(-0.5f * (float)(h + 1)) * 1.4426950408889634f;
        const size_t headoff = (size_t)(b * NH + h) * SEQ * HD;
        v4u pkA[4], pvA[4], pkB[4], pvB[4]; bf16x8 qA0, qA1, qB0, qB1; v4u opA[2], opB[2]; float lpA, lpB;
        att_prefetch(Q, K, V, headoff, b, h, sp, 0, skk, spart, w, fr, fq, pkA, pvA, qA0, qA1, O, LSE, opA, lpA);
        att_prefetch(Q, K, V, headoff, b, h, sp, 1, skk, spart, w, fr, fq, pkB, pvB, qB0, qB1, O, LSE, opB, lpB);
#pragma unroll 1
        for (int bi = 0; bi < 48; bi += 2) {
            att_block<MODE>(Q, K, V, O, LSE, lds, headoff, slope2, b, h, sp, bi, skk, spart, w, fr, fq, pkA, pvA, qA0, qA1, opA, lpA);
            att_block<MODE>(Q, K, V, O, LSE, lds, headoff, slope2, b, h, sp, bi + 1, skk, spart, w, fr, fq, pkB, pvB, qB0, qB1, opB, lpB);
        }
        asm volatile("s_waitcnt vmcnt(0)" ::: "memory");
        __syncthreads();
    }
}

#define XB_TMO      128
#define XB_XCNT(j)  (256  + 64 * (j))
#define XB_XSUB(j)  (1280 + 64 * (j))
#define XB_XGEN(j)  (2304 + 64 * (j))
#define XB_TOP      3328
#define XB_TOPGEN   3392
#define XCD_BAR_WORDS 3456
#define XB_SPIN_CAP (1u << 22)
__device__ __forceinline__ unsigned xb_ld(unsigned* p)              { return __hip_atomic_load(p, __ATOMIC_RELAXED, __HIP_MEMORY_SCOPE_AGENT); }
__device__ __forceinline__ unsigned xb_add(unsigned* p, unsigned v) { return __hip_atomic_fetch_add(p, v, __ATOMIC_RELAXED, __HIP_MEMORY_SCOPE_AGENT); }
__device__ __forceinline__ unsigned xb_xcc_id() { return (unsigned)__builtin_amdgcn_s_getreg((3 << 11) | 20) & 0xFu; }
#define XB_SPIN(cond, bar) do { unsigned _sp = 0; while (cond) { __builtin_amdgcn_s_sleep(1); \
    if ((++_sp & 255u) == 0u) { if (xb_ld(&(bar)[XB_TMO])) break; if (_sp > XB_SPIN_CAP) { atomicAdd(&(bar)[XB_TMO], 1u); break; } } } } while (0)
struct XcdBarrier { unsigned* bar; unsigned x; volatile LAS unsigned* st; };
__device__ __forceinline__ XcdBarrier xcd_barrier_post(unsigned* bar, volatile LAS unsigned* st) {
    XcdBarrier b; b.bar = bar; b.x = xb_xcc_id(); b.st = st;
    if (threadIdx.x == 0) (void)xb_add(&bar[XB_XCNT(b.x)], 1u);
    return b;
}
__device__ __forceinline__ void xcd_barrier_complete(unsigned* bar, unsigned x, unsigned& nloc, unsigned& nx) {
    const unsigned G = gridDim.x * gridDim.y * gridDim.z;
    unsigned sum, cnt, mine, sp = 0u;
    for (;;) {
        sum = 0u; cnt = 0u; mine = 0u;
#pragma unroll
        for (unsigned j = 0; j < 16; ++j) { const unsigned c = xb_ld(&bar[XB_XCNT(j)]); sum += c; cnt += (c > 0u) ? 1u : 0u; mine = (j == x) ? c : mine; }
        if (sum == G) break;
        __builtin_amdgcn_s_sleep(1);
        if ((++sp & 255u) == 0u) { if (xb_ld(&bar[XB_TMO])) break; if (sp > XB_SPIN_CAP) { atomicAdd(&bar[XB_TMO], 1u); break; } }
    }
    nloc = mine > 0u ? mine : 1u; nx = cnt > 0u ? cnt : 1u;
}
__device__ __forceinline__ void xcd_barrier(const XcdBarrier& b) {
    asm volatile("s_waitcnt vmcnt(0)" ::: "memory");
    __syncthreads();
    if (threadIdx.x == 0) {
        unsigned* bar = b.bar;
        __builtin_amdgcn_s_waitcnt(0);
        unsigned nloc = b.st[0], nx = b.st[1];
        if (nloc == 0u) { xcd_barrier_complete(bar, b.x, nloc, nx); b.st[0] = nloc; b.st[1] = nx; }
        const unsigned old = xb_add(&bar[XB_XSUB(b.x)], 1u);
        const unsigned gen = old / nloc;
        if (old + 1u == (gen + 1u) * nloc) {
            __builtin_amdgcn_fence(__ATOMIC_RELEASE, "agent");
            asm volatile("s_waitcnt vmcnt(0)" ::: "memory");
            const unsigned og = xb_add(&bar[XB_TOP], 1u);
            const unsigned tg = og / nx;
            if (og + 1u == (tg + 1u) * nx) xb_add(&bar[XB_TOPGEN], 1u);
            else XB_SPIN(xb_ld(&bar[XB_TOPGEN]) == tg, bar);
            __builtin_amdgcn_fence(__ATOMIC_ACQUIRE, "agent");
            xb_add(&bar[XB_XGEN(b.x)], 1u);
            asm volatile("s_waitcnt vmcnt(0)" ::: "memory");
        } else {
            XB_SPIN(xb_ld(&bar[XB_XGEN(b.x)]) == gen, bar);
            __builtin_amdgcn_fence(__ATOMIC_ACQUIRE, "agent");
            asm volatile("s_waitcnt vmcnt(0)" ::: "memory");
        }
    }
    __syncthreads();
}

__global__ void __launch_bounds__(NT, 2) fwd_kernel(Args a) {
    extern __shared__ __attribute__((aligned(16))) unsigned char lds_raw[];
    LAS unsigned char* lds = (LAS unsigned char*)lds_raw;
    cg::grid_group grid = cg::this_grid();
    const int G = gridDim.x, bid = blockIdx.x;
    if (threadIdx.x < 64) ((LAS unsigned*)(lds + 131072))[threadIdx.x] = 0u;
    __syncthreads();
    const XcdBarrier xbar = xcd_barrier_post((unsigned*)(a.ws + WS_CTL) + 4096, (volatile LAS unsigned*)(lds + 131072) + 8);
#define GSYNC() xcd_barrier(xbar)
#define PHASE_VARS() unsigned char* ws = opq(a.ws); float* out = opq(a.out); const int tid = opqv((int)threadIdx.x), lane = tid & 63, wave = __builtin_amdgcn_readfirstlane(tid >> 6); \
    const int gw = bid * NWAVES + wave, NGW = G * NWAVES; bf16* XN = (bf16*)(ws + WS_XN); LAS float* scr = (LAS float*)(lds + wave * 16384); (void)out; (void)lane; (void)gw; (void)NGW; (void)XN; (void)scr;

    {
        PHASE_VARS();
        { v4u* xbz = (v4u*)(ws + WS_XB); for (int i = bid * NT + tid; i < (int)(4 * MiB / 16); i += G * NT) xbz[i] = (v4u){0u, 0u, 0u, 0u}; }
        convert_layer(a, 0, ws + WS_W0, scr, gw, NGW, lane);
        const float* x = opq(a.in[0]);
        for (int m = gw; m < M; m += 2 * NGW) {
            const f32x4* xa = (const f32x4*)(x + (size_t)m * D) + lane; const f32x4* xb = (const f32x4*)(x + (size_t)(m + NGW) * D) + lane;
            f32x4 va[4], vb[4]; float sa = 0.f, sb = 0.f;
#pragma unroll
            for (int j = 0; j < 4; ++j) { va[j] = xa[64 * j]; vb[j] = xb[64 * j]; }
#pragma unroll
            for (int j = 0; j < 4; ++j) { sa += (va[j].x * va[j].x + va[j].y * va[j].y) + (va[j].z * va[j].z + va[j].w * va[j].w); sb += (vb[j].x * vb[j].x + vb[j].y * vb[j].y) + (vb[j].z * vb[j].z + vb[j].w * vb[j].w); }
            const float ra = 1.f / sqrtf(wave_sum(sa) * (1.f / D) + EPS), rb = 1.f / sqrtf(wave_sum(sb) * (1.f / D) + EPS);
            unsigned long long* oa = (unsigned long long*)(XN + (size_t)m * D) + lane; unsigned long long* ob = (unsigned long long*)(XN + (size_t)(m + NGW) * D) + lane;
#pragma unroll
            for (int j = 0; j < 4; ++j) { oa[64 * j] = (unsigned long long)pk2(va[j].x * ra, va[j].y * ra) | ((unsigned long long)pk2(va[j].z * ra, va[j].w * ra) << 32);
                ob[64 * j] = (unsigned long long)pk2(vb[j].x * rb, vb[j].y * rb) | ((unsigned long long)pk2(vb[j].z * rb, vb[j].w * rb) << 32); }
        }
    }
    grid.sync();

#pragma unroll 1
    for (int l = 0; l < DEPTH; ++l) {
        const bool isA = l < 2;
        {
            unsigned char* ws = opq(a.ws); unsigned char* wl = ws + ((l & 1) ? WS_W1 : WS_W0);
            const int N1 = (l == 3) ? D : 3 * D;
            pg8::Gemm g{(const bf16*)(ws + WS_XN), (const bf16*)(wl + WO_1), M, N1, D}; pg8::StaticOrder S; S.init(M, N1, G, bid);
            pg8::EpiBf16 E;
            E.O2 = (bf16*)(ws + WS_KV); E.cmul = isA ? 1 : 0;
            if (isA) { E.O = (bf16*)(ws + WS_G); E.ldc = D; E.split_cols = 0; E.split_stride = 0; E.hm = 0; }
            else if (l == 2) { E.O = (bf16*)(ws + WS_KV); E.ldc = D; E.split_cols = D; E.split_stride = (size_t)M * D; E.hm = 1; }
            else { E.O = (bf16*)(ws + WS_H); E.ldc = D; E.split_cols = 0; E.split_stride = 0; E.hm = 0; }
            pg8::gemm_phase<pg8::EpiBf16, pg8::StaticOrder, true, true>(lds, g, S, E);
        }
        GSYNC();
        {
            PHASE_VARS();
            if (isA) conv_phase((const bf16*)(ws + WS_G), (const bf16*)(ws + WS_KV), opq(a.in[3]) + (size_t)l * 3 * D, (bf16*)(ws + WS_H), bid, G, tid);
            else attn_fast<15>((const bf16*)(ws + WS_H), (const bf16*)(ws + WS_KV), (const bf16*)(ws + WS_KV + 64 * MiB), (bf16*)(ws + WS_H + 64 * MiB), (float*)(ws + WS_LSE), lds, bid, G, tid);
            __syncthreads();
            if (l + 1 < DEPTH) convert_layer(a, l + 1, ws + ((l & 1) ? WS_W0 : WS_W1), scr, gw, NGW, lane);
        }
        GSYNC();
#pragma unroll 1
        for (int round = 0; round < 2; ++round) {
            unsigned char* ws = opq(a.ws); unsigned char* wl = ws + ((l & 1) ? WS_W1 : WS_W0);
            pg8::Gemm g{isA ? (const bf16*)(ws + WS_H) : (const bf16*)(ws + WS_H + 64 * MiB), (const bf16*)(wl + WO_3), M, D, D};
            pg8::RoundOrder S; S.so.init(M, D, G, bid); S.round = round;
            unsigned long long* xb = (unsigned long long*)(ws + WS_XB);
            pg8::EpiRmsResRms E; E.base = (l == 0) ? opq(a.in[0]) : nullptr; E.out = opq(a.out); E.xn = (bf16*)(ws + WS_XN); E.gain = opq(a.in[1]) + (size_t)l * 4 * D + D; E.write_xn = 1; E.write_out = 0;
            E.inv_in = (const float*)(ws + WS_INV) + M; E.inv_out = (float*)(ws + WS_INV);
            E.st1.xbuf = xb; E.st1.tag = (unsigned)(l + 1);
            E.st2.xbuf = xb + (size_t)M * 4; E.st2.tag = (unsigned)(l + 1);
            pg8::gemm_phase<pg8::EpiRmsResRms, pg8::RoundOrder, false, true>(lds, g, S, E);
            __syncthreads();
        }
        GSYNC();
        {
            unsigned char* ws = opq(a.ws); unsigned char* wl = ws + ((l & 1) ? WS_W1 : WS_W0);
            pg8::Gemm g{(const bf16*)(ws + WS_XN), (const bf16*)(wl + WO_FI), M, 2 * FF, D}; pg8::StaticOrder S; S.init(M, 2 * FF, G, bid);
            pg8::EpiSwiGLU E; E.O = (bf16*)(ws + WS_H); E.ldc = FF;
            pg8::gemm_phase<pg8::EpiSwiGLU, pg8::StaticOrder, true, true>(lds, g, S, E);
        }
        GSYNC();
#pragma unroll 1
        for (int round = 0; round < 2; ++round) {
            unsigned char* ws = opq(a.ws); unsigned char* wl = ws + ((l & 1) ? WS_W1 : WS_W0);
            pg8::Gemm g{(const bf16*)(ws + WS_H), (const bf16*)(wl + WO_FO), M, D, FF};
            pg8::RoundOrder S; S.so.init(M, D, G, bid); S.round = round;
            unsigned long long* xb = (unsigned long long*)(ws + WS_XB) + (size_t)M * 8;
            pg8::EpiRmsResRms E; E.base = nullptr; E.out = opq(a.out); E.xn = (bf16*)(ws + WS_XN); E.gain = opq(a.in[1]) + (size_t)l * 4 * D + 3 * D; E.write_xn = (l + 1 < DEPTH) ? 1 : 0; E.write_out = (l + 1 < DEPTH) ? 0 : 1;
            E.inv_in = (const float*)(ws + WS_INV); E.inv_out = (float*)(ws + WS_INV) + M;
            E.st1.xbuf = xb; E.st1.tag = (unsigned)(l + 1);
            E.st2.xbuf = xb + (size_t)M * 4; E.st2.tag = (unsigned)(l + 1);
            pg8::gemm_phase<pg8::EpiRmsResRms, pg8::RoundOrder, false, true>(lds, g, S, E);
            __syncthreads();
        }
        if (l + 1 < DEPTH) GSYNC();
    }
}

extern "C" void kernel_launch(void* const* d_in, const int* in_sizes, int n_in, void* d_out, int out_size, void* d_ws, size_t ws_size, hipStream_t stream) {
    static int grid = 0;
    if (grid == 0) {
        if (n_in != 11 || ws_size < WS_END) { fprintf(stderr, "kernel_launch: unexpected n_in %d / ws_size %zu\n", n_in, ws_size); grid = -1; return; }
        int dev = 0, cus = 0, per_cu = 0;
        hipGetDevice(&dev);
        hipDeviceGetAttribute(&cus, hipDeviceAttributeMultiprocessorCount, dev);
        hipFuncSetAttribute((const void*)fwd_kernel, hipFuncAttributeMaxDynamicSharedMemorySize, LDS_BYTES);
        if (hipOccupancyMaxActiveBlocksPerMultiprocessor(&per_cu, (const void*)fwd_kernel, NT, LDS_BYTES) != hipSuccess || per_cu < 1) per_cu = 1;
        (void)hipGetLastError();
        grid = cus * per_cu;
        if (grid >= 256) grid = 256;
    }
    if (grid < 0) return;
    if (hipMemsetAsync((char*)d_ws + WS_CTL, 0, 64 * 1024, stream) != hipSuccess) { fprintf(stderr, "memset failed\n"); return; }
    Args a{};
    for (int i = 0; i < 11; ++i) a.in[i] = (const float*)d_in[i];
    a.out = (float*)d_out; a.ws = (unsigned char*)d_ws;
    void* args[] = {&a};
    hipError_t e = hipLaunchCooperativeKernel((const void*)fwd_kernel, dim3(grid), dim3(NT), args, LDS_BYTES, stream);
    if (e != hipSuccess) fprintf(stderr, "cooperative launch failed: %s (grid %d)\n", hipGetErrorString(e), grid);
}
```

```cpp
#include <hip/hip_runtime.h>
#include <hip/hip_cooperative_groups.h>
#include <cstdio>
#include <cstdint>
namespace cg = cooperative_groups;

namespace pg8 {
#define PG8_LAS __attribute__((address_space(3)))
typedef unsigned short bf16_t;
typedef short bf16x8 __attribute__((ext_vector_type(8)));
typedef float f32x4 __attribute__((ext_vector_type(4)));
typedef unsigned u32x4 __attribute__((ext_vector_type(4)));
constexpr int BM = 256, BK = 64, HALF = 128, HTB = HALF * BK * 2, STAGE_BYTES = 8 * HTB, NXCD = 8, WGM = 8;

__host__ __device__ __forceinline__ int lds_byte(int r, int c) { const int st = (r >> 4) * 2 + (c >> 5), rr = r & 15, cc = c & 31, ob = rr * 64 + cc * 2; return st * 1024 + (ob ^ (((ob >> 9) & 1) << 5)); }
__host__ __device__ __forceinline__ void stage_rc(int b, int& R, int& C) { const int st = b / 1024, sb = b % 1024, swz = sb ^ (((sb >> 9) & 1) << 5); R = (st >> 1) * 16 + swz / 64; C = (st & 1) * 32 + (swz % 64) / 2; }
__host__ __device__ __forceinline__ int perm32(int rho) { const int n = rho >> 4, i = rho & 15; return 8 * (i >> 2) + 4 * n + (i & 3); }

struct Unit { int pm, pn; };
struct Gemm { const bf16_t* A; const bf16_t* Bt; int M, N, K; };

struct StaticOrder {
    int nM, nN, nwg, G, c;
    __host__ __device__ void init(int M, int N, int G_, int c_) { nM = M / BM; nN = N / BM; nwg = nM * nN; G = G_; c = c_; }
    __host__ __device__ bool next(int i, Unit& u) const { return at(i, u); }
    __host__ __device__ bool at(int i, Unit& u) const {
        const long L = (long)i * G + c; if (L >= nwg) return false;
        int wgid = (int)L; { const int q = nwg / NXCD, r = nwg % NXCD, xcd = wgid % NXCD, off = wgid / NXCD; wgid = (xcd < r ? xcd * (q + 1) : r * (q + 1) + (xcd - r) * q) + off; }
        const int nig = WGM * nN, gid = wgid / nig, fm = gid * WGM, gsz = (nM - fm) < WGM ? (nM - fm) : WGM;
        u.pm = fm + ((wgid % nig) % gsz); u.pn = (wgid % nig) / gsz; return true;
    }
    __device__ __forceinline__ void a_ready(const Unit&) const {}
    __device__ __forceinline__ void done(const Unit&) const {}
};

struct RoundOrder {
    StaticOrder so; int round;
    __device__ __forceinline__ bool next(int i, Unit& u) const { if (i > 0) return false; return so.at(round, u); }
    __device__ __forceinline__ void a_ready(const Unit&) const {}
    __device__ __forceinline__ void done(const Unit&) const {}
};
__device__ __forceinline__ unsigned cvt_pk_bf16(float lo, float hi) { unsigned r; asm("v_cvt_pk_bf16_f32 %0, %1, %2" : "=v"(r) : "v"(lo), "v"(hi)); return r; }

struct EpiBf16 {
    static constexpr bool PERM = true, AFTER_DRAIN = false;
    bf16_t* O; int ldc; int split_cols; size_t split_stride; int hm; bf16_t* O2; int cmul;
    __device__ __forceinline__ void operator()(const f32x4 (&acc)[2][2][4][2], const Unit& u, int wr, int wc, int fr, int fq) const {
        if (cmul && u.pn >= 4) {
            const int row0 = u.pm * BM + wr * 64 + fr, col0 = (u.pn - 4) * HALF + wc * 32 + 8 * fq;
#pragma unroll
            for (int ai = 0; ai < 2; ++ai)
#pragma unroll
                for (int m = 0; m < 4; ++m) { const f32x4 v0 = acc[ai][0][m][0] * acc[ai][1][m][0], v1 = acc[ai][0][m][1] * acc[ai][1][m][1];
                    u32x4 w; w.x = cvt_pk_bf16(v0[0], v0[1]); w.y = cvt_pk_bf16(v0[2], v0[3]); w.z = cvt_pk_bf16(v1[0], v1[1]); w.w = cvt_pk_bf16(v1[2], v1[3]);
                    *(u32x4*)(O2 + (size_t)(row0 + ai * HALF + m * 16) * 1024 + col0) = w; }
            return;
        }
        const int row0 = u.pm * BM + wr * 64 + fr; int colt = u.pn * BM; bf16_t* base = O; int t = 0;
        if (split_cols) { t = colt / split_cols; base += (size_t)t * split_stride; colt -= t * split_cols; }
        const int col0 = colt + wc * 32 + 8 * fq;
        const bool headmajor = hm && t < 2;
#pragma unroll
        for (int ai = 0; ai < 2; ++ai)
#pragma unroll
            for (int m = 0; m < 4; ++m) { const int row = row0 + ai * HALF + m * 16;
                bf16_t* rowp = headmajor ? base + ((size_t)((row >> 13) * 16 + (col0 >> 6)) * 8192 + (row & 8191)) * 64 + (col0 & 63) : base + (size_t)row * ldc + col0;
                const size_t bjstep = headmajor ? (size_t)2 * 8192 * 64 : (size_t)HALF;
#pragma unroll
                for (int bj = 0; bj < 2; ++bj) { const f32x4 v0 = acc[ai][bj][m][0], v1 = acc[ai][bj][m][1];
                    u32x4 w; w.x = cvt_pk_bf16(v0[0], v0[1]); w.y = cvt_pk_bf16(v0[2], v0[3]); w.z = cvt_pk_bf16(v1[0], v1[1]); w.w = cvt_pk_bf16(v1[2], v1[3]);
                    *(u32x4*)(rowp + bj * bjstep) = w; } }
    }
};
__device__ __forceinline__ float silu_mul(float g, float u) { return g * u * __builtin_amdgcn_rcpf(1.0f + __expf(-g)); }
struct EpiSwiGLU {
    static constexpr bool PERM = true, AFTER_DRAIN = false;
    bf16_t* O; int ldc;
    __device__ __forceinline__ void operator()(const f32x4 (&acc)[2][2][4][2], const Unit& u, int wr, int wc, int fr, int fq) const {
        const int row0 = u.pm * BM + wr * 64 + fr; const int col0 = u.pn * HALF + wc * 32 + 8 * fq;
#pragma unroll
        for (int ai = 0; ai < 2; ++ai)
#pragma unroll
            for (int m = 0; m < 4; ++m) { bf16_t* rowp = O + (size_t)(row0 + ai * HALF + m * 16) * ldc + col0;
                const f32x4 g0 = acc[ai][0][m][0], g1 = acc[ai][0][m][1], u0 = acc[ai][1][m][0], u1 = acc[ai][1][m][1];
                u32x4 w; w.x = cvt_pk_bf16(silu_mul(g0[0], u0[0]), silu_mul(g0[1], u0[1])); w.y = cvt_pk_bf16(silu_mul(g0[2], u0[2]), silu_mul(g0[3], u0[3]));
                w.z = cvt_pk_bf16(silu_mul(g1[0], u1[0]), silu_mul(g1[1], u1[1])); w.w = cvt_pk_bf16(silu_mul(g1[2], u1[2]), silu_mul(g1[3], u1[3]));
                *(u32x4*)rowp = w; }
    }
};

struct RmsXchg {
    unsigned long long* xbuf;
    unsigned tag;
    __device__ __forceinline__ void run(const f32x4 (&v)[2][2][4][2], const Unit& u, int wr, int wc, int fr, int fq, PG8_LAS unsigned char* lds, int wid, int lane) const {
        PG8_LAS float* P = (PG8_LAS float*)lds;
        PG8_LAS float* S = (PG8_LAS float*)(lds + 4096);
#pragma unroll
        for (int ai = 0; ai < 2; ++ai)
#pragma unroll
            for (int m = 0; m < 4; ++m) {
                float q = 0.f;
#pragma unroll
                for (int bj = 0; bj < 2; ++bj)
#pragma unroll
                    for (int n = 0; n < 2; ++n) { const f32x4 x = v[ai][bj][m][n]; q += (x[0] * x[0] + x[1] * x[1]) + (x[2] * x[2] + x[3] * x[3]); }
                q += __shfl_xor(q, 16); q += __shfl_xor(q, 32);
                if (fq == 0) P[(ai * HALF + wr * 64 + m * 16 + fr) * 4 + wc] = q;
            }
        asm volatile("s_waitcnt lgkmcnt(0)" ::: "memory"); __builtin_amdgcn_s_barrier(); asm volatile("" ::: "memory");
        const int row = wid * 32 + (lane & 31);
        unsigned long long* slot = xbuf + (size_t)(u.pm * BM + row) * 4;
        if (lane < 32) { const f32x4 p = *(const PG8_LAS f32x4*)(P + row * 4); const float t = (p[0] + p[1]) + (p[2] + p[3]);
            __hip_atomic_store(slot + u.pn, ((unsigned long long)tag << 32) | (unsigned long long)__builtin_bit_cast(unsigned, t), __ATOMIC_RELAXED, __HIP_MEMORY_SCOPE_AGENT); }
        float tot = 0.f; unsigned sp = 0u;
        for (;;) {
            bool ok = true; tot = 0.f;
            if (lane < 32) {
#pragma unroll
                for (int k = 0; k < 4; ++k) { const unsigned long long wv = __hip_atomic_load(slot + k, __ATOMIC_RELAXED, __HIP_MEMORY_SCOPE_AGENT); ok = ok && ((unsigned)(wv >> 32) == tag); tot += __builtin_bit_cast(float, (unsigned)wv); }
            }
            if (__builtin_amdgcn_ballot_w64(!ok) == 0ull) break;
            if (++sp > (1u << 22)) break;
            __builtin_amdgcn_s_sleep(1);
        }
        if (lane < 32) S[row] = 1.0f / sqrtf(tot * (1.0f / 1024.0f) + 1e-6f);
        asm volatile("s_waitcnt lgkmcnt(0)" ::: "memory"); __builtin_amdgcn_s_barrier(); asm volatile("" ::: "memory");
    }
};
struct EpiRmsResRms {
    static constexpr bool PERM = true, AFTER_DRAIN = true;
    const float* base; float* out; bf16_t* xn; const float* gain; const float* inv_in; float* inv_out; RmsXchg st1, st2; int write_xn, write_out;
    __device__ __forceinline__ void fused(f32x4 (&acc)[2][2][4][2], const Unit& u, int wr, int wc, int fr, int fq, PG8_LAS unsigned char* lds, int wid, int lane) const {
        const PG8_LAS float* S = (const PG8_LAS float*)(lds + 4096);
        const int col0 = u.pn * BM + wc * 32 + 8 * fq;
        u32x4 pre[4][2]; float ivs[4], ivs1[4];
        if (!base) {
#pragma unroll
            for (int m = 0; m < 4; ++m) { const int r = wr * 64 + m * 16 + fr; const size_t off = (size_t)(u.pm * BM + r) * 1024 + col0; ivs[m] = inv_in[u.pm * BM + r]; ivs1[m] = inv_in[u.pm * BM + HALF + r];
#pragma unroll
                for (int bj = 0; bj < 2; ++bj) pre[m][bj] = *(const u32x4*)(xn + off + bj * HALF); }
        }
        f32x4 gq[2][2];
#pragma unroll
        for (int bj = 0; bj < 2; ++bj) { gq[bj][0] = *(const f32x4*)(gain + col0 + bj * HALF); gq[bj][1] = *(const f32x4*)(gain + col0 + bj * HALF + 4); }
        st1.run(acc, u, wr, wc, fr, fq, lds, wid, lane);
#pragma unroll
        for (int ai = 0; ai < 2; ++ai)
#pragma unroll
            for (int m = 0; m < 4; ++m) { const int r = ai * HALF + wr * 64 + m * 16 + fr; const float rs = S[r]; const size_t off = (size_t)(u.pm * BM + r) * 1024 + col0;
#pragma unroll
                for (int bj = 0; bj < 2; ++bj) { f32x4 b0, b1;
                    if (base) { b0 = *(const f32x4*)(base + off + bj * HALF); b1 = *(const f32x4*)(base + off + bj * HALF + 4); }
                    else { const u32x4 w = (ai == 0) ? pre[m][bj] : *(const u32x4*)(xn + off + bj * HALF); const float iv = (ai == 0) ? ivs[m] : ivs1[m];
                        b0 = (f32x4){__builtin_bit_cast(float, w.x << 16), __builtin_bit_cast(float, w.x & 0xffff0000u), __builtin_bit_cast(float, w.y << 16), __builtin_bit_cast(float, w.y & 0xffff0000u)} * iv;
                        b1 = (f32x4){__builtin_bit_cast(float, w.z << 16), __builtin_bit_cast(float, w.z & 0xffff0000u), __builtin_bit_cast(float, w.w << 16), __builtin_bit_cast(float, w.w & 0xffff0000u)} * iv; }
                    acc[ai][bj][m][0] = b0 + acc[ai][bj][m][0] * rs * gq[bj][0]; acc[ai][bj][m][1] = b1 + acc[ai][bj][m][1] * rs * gq[bj][1]; }
                asm volatile("" : "+v"(acc[ai][0][m][0]), "+v"(acc[ai][0][m][1]), "+v"(acc[ai][1][m][0]), "+v"(acc[ai][1][m][1]));
                if (m & 1) asm volatile("" ::: "memory"); }
        if (write_xn) st2.run(acc, u, wr, wc, fr, fq, lds, wid, lane);
#pragma unroll
        for (int ai = 0; ai < 2; ++ai)
#pragma unroll
            for (int m = 0; m < 4; ++m) { const int r = ai * HALF + wr * 64 + m * 16 + fr; const float rs = S[r]; const size_t off = (size_t)(u.pm * BM + r) * 1024 + col0;
#pragma unroll
                for (int bj = 0; bj < 2; ++bj) { const f32x4 x0 = acc[ai][bj][m][0], x1 = acc[ai][bj][m][1];
                    if (write_out) { *(f32x4*)(out + off + bj * HALF) = x0; *(f32x4*)(out + off + bj * HALF + 4) = x1; }
                    if (write_xn) { const f32x4 o0 = x0 * rs, o1 = x1 * rs; u32x4 w; w.x = cvt_pk_bf16(o0[0], o0[1]); w.y = cvt_pk_bf16(o0[2], o0[3]); w.z = cvt_pk_bf16(o1[0], o1[1]); w.w = cvt_pk_bf16(o1[2], o1[3]);
                        *(u32x4*)(xn + off + bj * HALF) = w; } }
                asm volatile("" ::: "memory"); }
        if (write_xn && u.pn == 0 && lane < 32) inv_out[u.pm * BM + wid * 32 + lane] = 1.0f / S[wid * 32 + lane];
    }
};

template <class Epi, class Sched, bool ALIGN_EPI = false, bool SP2 = false>
__device__ __forceinline__ void gemm_phase(PG8_LAS unsigned char* lds, const Gemm g, const Sched& S, const Epi& E) {
    int tid = threadIdx.x; asm volatile("" : "+v"(tid));
    const int wid = __builtin_amdgcn_readfirstlane(tid >> 6), lane = tid & 63, wr = wid >> 2, wc = wid & 3, fr = lane & 15, fq = lane >> 4;
    const int K = g.K, nt = K / BK;
    unsigned voffA[2], voffB[2];
#pragma unroll
    for (int i = 0; i < 2; ++i) { int R, C; stage_rc(tid * 16 + i * 8192, R, C); const int Rb = Epi::PERM ? ((R & ~31) + perm32(R & 31)) : R;
        voffA[i] = (unsigned)(R * K + C) * 2u; voffB[i] = (unsigned)(Rb * K + C) * 2u; }
    const size_t kstep = (size_t)(BK * 2);
    const size_t hstep = (size_t)HALF * K * 2;
    const size_t tstep = 2 * hstep;
    const unsigned ldsw = (unsigned)wid * 1024u;
    const int aoff = lds_byte(wr * 64 + fr, fq * 8), boff = lds_byte(wc * 32 + fr, fq * 8);
#define PG8_SA(b, h) (((b) * 2 + (h)) * HTB)
#define PG8_SB(b, h) ((4 + (b) * 2 + (h)) * HTB)
#define PG8_STAGE(bufoff, gbase, voff) do { _Pragma("unroll") for (int _i = 0; _i < 2; ++_i) \
        __builtin_amdgcn_global_load_lds((const unsigned*)((const char*)(gbase) + (voff)[_i]), (PG8_LAS unsigned*)(lds + (bufoff) + ldsw + _i * 8192), 16, 0, 0); } while (0)
#define PG8_LDA(dst, b, h) do { _Pragma("unroll") for (int m = 0; m < 4; ++m) _Pragma("unroll") for (int k = 0; k < 2; ++k) dst[m][k] = *(const PG8_LAS bf16x8*)(lds + PG8_SA(b, h) + aoff + m * 2048 + k * 1024); } while (0)
#define PG8_LDB(dst, b, h) do { _Pragma("unroll") for (int n = 0; n < 2; ++n) _Pragma("unroll") for (int k = 0; k < 2; ++k) dst[n][k] = *(const PG8_LAS bf16x8*)(lds + PG8_SB(b, h) + boff + n * 2048 + k * 1024); } while (0)
#define PG8_MMA(ai, bj, At, Bt) do { __builtin_amdgcn_s_setprio(1); _Pragma("unroll") for (int m = 0; m < 4; ++m) _Pragma("unroll") for (int n = 0; n < 2; ++n) _Pragma("unroll") for (int k = 0; k < 2; ++k) \
        acc[ai][bj][m][n] = __builtin_amdgcn_mfma_f32_16x16x32_bf16(Bt[n][k], At[m][k], acc[ai][bj][m][n], 0, 0, 0); __builtin_amdgcn_s_setprio(0); } while (0)
#define PG8_WAIT_V(n) asm volatile("s_waitcnt vmcnt(" #n ")" ::: "memory")
#define PG8_WAIT_L(n) asm volatile("s_waitcnt lgkmcnt(" #n ")" ::: "memory")
#define PG8_BAR __builtin_amdgcn_s_barrier()
#define PG8_SCHED __builtin_amdgcn_sched_barrier(0)
    Unit cur, nxt; int ui = 0;
    if (!S.next(0, cur)) return;
    f32x4 acc[2][2][4][2];
#pragma unroll
    for (int a = 0; a < 2; ++a)
#pragma unroll
        for (int b = 0; b < 2; ++b)
#pragma unroll
            for (int m = 0; m < 4; ++m)
#pragma unroll
                for (int n = 0; n < 2; ++n) acc[a][b][m][n] = (f32x4){0.f, 0.f, 0.f, 0.f};
    bf16x8 At[4][2], B0[2][2], B1[2][2];
    const char* cA = (const char*)g.A + (size_t)cur.pm * tstep; const char* cB = (const char*)g.Bt + (size_t)cur.pn * tstep;
    S.a_ready(cur);
    if constexpr (SP2) {
        PG8_STAGE(PG8_SB(0, 0), cB, voffB); PG8_STAGE(PG8_SB(0, 1), cB + hstep, voffB); PG8_STAGE(PG8_SA(0, 0), cA, voffA); PG8_STAGE(PG8_SA(0, 1), cA + hstep, voffA);
        if (wr == 1) PG8_BAR;
        PG8_WAIT_V(2); PG8_BAR;
        PG8_STAGE(PG8_SB(1, 0), cB + kstep, voffB); PG8_STAGE(PG8_SA(1, 0), cA + kstep, voffA); PG8_STAGE(PG8_SB(1, 1), cB + hstep + kstep, voffB);
        PG8_WAIT_V(6); PG8_BAR;
    } else {
        PG8_STAGE(PG8_SB(0, 0), cB, voffB); PG8_STAGE(PG8_SA(0, 0), cA, voffA); PG8_STAGE(PG8_SB(0, 1), cB + hstep, voffB); PG8_STAGE(PG8_SA(0, 1), cA + hstep, voffA);
        if (wr == 1) PG8_BAR;
        PG8_WAIT_V(4); PG8_BAR;
        PG8_STAGE(PG8_SB(1, 0), cB + kstep, voffB); PG8_STAGE(PG8_SA(1, 0), cA + kstep, voffA); PG8_STAGE(PG8_SB(1, 1), cB + hstep + kstep, voffB);
        PG8_WAIT_V(6); PG8_BAR;
    }
    for (;;) {
        const bool has_next = S.next(ui + 1, nxt);
        const char* nA = has_next ? (const char*)g.A + (size_t)nxt.pm * tstep : cA; const char* nB = has_next ? (const char*)g.Bt + (size_t)nxt.pn * tstep : cB;
        for (int t = 0; t < nt; t += 2) {
            const bool last = (t == nt - 2);
            const char* a1 = cA + (size_t)(t + 1) * kstep;
            const char* a2 = last ? nA : cA + (size_t)(t + 2) * kstep; const char* b2 = last ? nB : cB + (size_t)(t + 2) * kstep;
            const char* a3 = a2 + kstep; const char* b3 = b2 + kstep;
            if (last && has_next) S.a_ready(nxt);
            if constexpr (SP2) {
            PG8_LDB(B0, 0, 0); PG8_LDB(B1, 0, 1); PG8_SCHED; PG8_LDA(At, 0, 0); PG8_STAGE(PG8_SA(1, 1), a1 + hstep, voffA);
            PG8_WAIT_V(8); PG8_WAIT_L(0); PG8_BAR; PG8_MMA(0, 0, At, B0); PG8_MMA(0, 1, At, B1); PG8_BAR; PG8_SCHED;
            PG8_LDA(At, 0, 1); PG8_STAGE(PG8_SB(0, 0), b2, voffB); PG8_STAGE(PG8_SB(0, 1), b2 + hstep, voffB); PG8_STAGE(PG8_SA(0, 0), a2, voffA);
            PG8_WAIT_V(8); PG8_WAIT_L(0); PG8_BAR; PG8_MMA(1, 0, At, B0); PG8_MMA(1, 1, At, B1); PG8_BAR; PG8_SCHED;
            PG8_LDB(B0, 1, 0); PG8_LDB(B1, 1, 1); PG8_SCHED; PG8_LDA(At, 1, 0); PG8_STAGE(PG8_SA(0, 1), a2 + hstep, voffA);
            PG8_WAIT_V(8); PG8_WAIT_L(0); PG8_BAR; PG8_MMA(0, 0, At, B0); PG8_MMA(0, 1, At, B1); PG8_BAR; PG8_SCHED;
            PG8_LDA(At, 1, 1); PG8_STAGE(PG8_SB(1, 0), b3, voffB); PG8_STAGE(PG8_SB(1, 1), b3 + hstep, voffB); PG8_STAGE(PG8_SA(1, 0), a3, voffA);
            PG8_WAIT_V(8); PG8_WAIT_L(0); PG8_BAR; PG8_MMA(1, 0, At, B0); PG8_MMA(1, 1, At, B1); PG8_BAR; PG8_SCHED;
            } else {
            PG8_LDB(B0, 0, 0); PG8_SCHED; PG8_LDA(At, 0, 0); PG8_STAGE(PG8_SA(1, 1), a1 + hstep, voffA);
            PG8_WAIT_L(8); PG8_BAR; PG8_WAIT_L(0); PG8_MMA(0, 0, At, B0); PG8_BAR; PG8_SCHED;
            PG8_LDB(B1, 0, 1); PG8_STAGE(PG8_SB(0, 0), b2, voffB);
            PG8_BAR; PG8_WAIT_L(0); PG8_MMA(0, 1, At, B1); PG8_BAR;
            PG8_LDA(At, 0, 1); PG8_STAGE(PG8_SA(0, 0), a2, voffA);
            PG8_BAR; PG8_WAIT_L(0); PG8_MMA(1, 0, At, B0); PG8_BAR; PG8_SCHED;
            PG8_STAGE(PG8_SB(0, 1), b2 + hstep, voffB);
            PG8_WAIT_V(6); PG8_BAR; PG8_MMA(1, 1, At, B1); PG8_BAR;
            PG8_LDB(B0, 1, 0); PG8_SCHED; PG8_LDA(At, 1, 0); PG8_STAGE(PG8_SA(0, 1), a2 + hstep, voffA);
            PG8_WAIT_L(8); PG8_BAR; PG8_WAIT_L(0); PG8_MMA(0, 0, At, B0); PG8_BAR; PG8_SCHED;
            PG8_LDB(B1, 1, 1); PG8_STAGE(PG8_SB(1, 0), b3, voffB);
            PG8_BAR; PG8_WAIT_L(0); PG8_MMA(0, 1, At, B1); PG8_BAR;
            PG8_LDA(At, 1, 1); PG8_STAGE(PG8_SA(1, 0), a3, voffA);
            PG8_BAR; PG8_WAIT_L(0); PG8_MMA(1, 0, At, B0); PG8_BAR; PG8_SCHED;
            PG8_STAGE(PG8_SB(1, 1), b3 + hstep, voffB);
            PG8_WAIT_V(6); PG8_BAR; PG8_MMA(1, 1, At, B1); PG8_BAR;
            }
        }
        if constexpr (ALIGN_EPI) { if (wr == 0) PG8_BAR; }
        if constexpr (!Epi::AFTER_DRAIN) { E(acc, cur, wr, wc, fr, fq); S.done(cur); }
        if (!has_next) break;
#pragma unroll
        for (int a = 0; a < 2; ++a)
#pragma unroll
            for (int b = 0; b < 2; ++b)
#pragma unroll
                for (int m = 0; m < 4; ++m)
#pragma unroll
                    for (int n = 0; n < 2; ++n) acc[a][b][m][n] = (f32x4){0.f, 0.f, 0.f, 0.f};
        cur = nxt; cA = nA; cB = nB; ++ui;
        if constexpr (ALIGN_EPI) { if (wr == 1) PG8_BAR; }
    }
    PG8_WAIT_V(0);
    if constexpr (!ALIGN_EPI) { if (wr == 0) PG8_BAR; }
    PG8_BAR;
    if constexpr (Epi::AFTER_DRAIN) { E.fused(acc, cur, wr, wc, fr, fq, lds, wid, lane); S.done(cur); }
#undef PG8_SA
#undef PG8_SB
#undef PG8_STAGE
#undef PG8_LDA
#undef PG8_LDB
#undef PG8_MMA
#undef PG8_WAIT_V
#undef PG8_WAIT_L
#undef PG8_BAR
#undef PG8_SCHED
}
}

#define LAS __attribute__((address_space(3)))
typedef unsigned short bf16;
typedef unsigned v4u __attribute__((ext_vector_type(4)));
typedef unsigned v2u __attribute__((ext_vector_type(2)));
typedef float f32x4 __attribute__((ext_vector_type(4)));
constexpr int NWAVES = 8, NT = 512;
constexpr int BATCH = 4, SEQ = 8192, D = 1024, M = BATCH * SEQ, NH = 16, HD = 64, FF = 2816, DEPTH = 4;
constexpr float EPS = 1e-6f;
constexpr size_t MiB = 1u << 20;
constexpr size_t WS_CTL = 0, WS_LSE = 1 * MiB, WS_W0 = 4 * MiB, WS_W1 = 29 * MiB, WS_XN = 54 * MiB, WS_G = 118 * MiB, WS_KV = 182 * MiB, WS_H = 310 * MiB, WS_XB = 486 * MiB, WS_INV = 490 * MiB, WS_END = 491 * MiB;
constexpr int CW_SEAM = 16384, SEAM_BANK = 128 * 64;
constexpr size_t WO_1 = 0, WO_3 = 6 * MiB, WO_FI = 8 * MiB, WO_FO = 19 * MiB;
constexpr int LDS_BYTES = 131072 + 1024;

struct Args { const float* in[11]; float* out; unsigned char* ws; };

__device__ __forceinline__ unsigned f2bf(float f) { unsigned u = __builtin_bit_cast(unsigned, f); return (u + 0x7fffu + ((u >> 16) & 1u)) >> 16; }
__device__ __forceinline__ unsigned pk2(float lo, float hi) { return f2bf(lo) | (f2bf(hi) << 16); }
__device__ __forceinline__ float bflo(unsigned w) { return __builtin_bit_cast(float, w << 16); }
__device__ __forceinline__ float bfhi(unsigned w) { return __builtin_bit_cast(float, w & 0xffff0000u); }
__device__ __forceinline__ float wave_sum(float v) {
#pragma unroll
    for (int o = 1; o < 64; o <<= 1) v += __shfl_xor(v, o);
    return v;
}
__device__ __forceinline__ float wave_max(float v) {
#pragma unroll
    for (int o = 1; o < 64; o <<= 1) v = fmaxf(v, __shfl_xor(v, o));
    return v;
}
#define LDS_WAIT() asm volatile("s_waitcnt lgkmcnt(0)" ::: "memory")
template <class T> __device__ __forceinline__ T* opq(T* p) { size_t z = 0; asm volatile("" : "+s"(z)); return (T*)((unsigned char*)p + z); }
__device__ __forceinline__ int opqv(int v) { asm volatile("" : "+v"(v)); return v; }

__device__ __forceinline__ void tr_item(const float* W, int K, int N, const float* gain, float scale, bf16* WT, int swiglu, int row_off, LAS float* scr, int item, int lane) {
    const int nblk = N / 32, kb = item / nblk, nb = item % nblk, k0 = 64 * kb, n0 = 32 * nb;
    {
        const int kq = lane >> 3, n4 = (lane & 7) * 4;
        f32x4 wv[8];
#pragma unroll
        for (int i = 0; i < 8; ++i) wv[i] = *(const f32x4*)(W + (size_t)(k0 + 8 * i + kq) * N + n0 + n4);
#pragma unroll
        for (int i = 0; i < 8; ++i) { const int kk = 8 * i + kq; const float gk = gain ? gain[k0 + kk] * scale : scale;
            scr[kk * 33 + n4 + 0] = wv[i][0] * gk; scr[kk * 33 + n4 + 1] = wv[i][1] * gk; scr[kk * 33 + n4 + 2] = wv[i][2] * gk; scr[kk * 33 + n4 + 3] = wv[i][3] * gk; }
    }
    LDS_WAIT(); asm volatile("" ::: "memory");
    int drow0 = n0;
    if (swiglu == 1) drow0 = (n0 < FF) ? ((n0 >> 7) * 256 + (n0 & 127)) : (((n0 - FF) >> 7) * 256 + 128 + ((n0 - FF) & 127));
    if (swiglu == 2) drow0 = (n0 < D) ? n0 : ((n0 < 2 * D) ? (D + ((n0 - D) >> 7) * 256 + ((n0 - D) & 127)) : (D + ((n0 - 2 * D) >> 7) * 256 + 128 + ((n0 - 2 * D) & 127)));
    drow0 += row_off;
    const int c = lane & 7;
#pragma unroll
    for (int j = 0; j < 4; ++j) { const int n = (lane >> 3) + 8 * j; const LAS float* s = scr + (8 * c) * 33 + n;
        v4u o; o.x = pk2(s[0 * 33], s[1 * 33]); o.y = pk2(s[2 * 33], s[3 * 33]); o.z = pk2(s[4 * 33], s[5 * 33]); o.w = pk2(s[6 * 33], s[7 * 33]);
        *(v4u*)(WT + (size_t)(drow0 + n) * K + k0 + 8 * c) = o; }
    LDS_WAIT(); asm volatile("" ::: "memory");
}
__device__ __forceinline__ void convert_layer(const Args& a, int l, unsigned char* wbuf, LAS float* scr, int gw, int NGW, int lane) {
    const float* ng = a.in[1] + (size_t)l * 4 * D;
    bf16* W1 = (bf16*)(wbuf + WO_1); bf16* W3 = (bf16*)(wbuf + WO_3); bf16* WFI = (bf16*)(wbuf + WO_FI); bf16* WFO = (bf16*)(wbuf + WO_FO);
    const int n0 = (l < 2) ? 1536 : (l == 2 ? 1024 : 0), n1 = (l < 2) ? 0 : 512, n2 = 512, n3 = 2816, n4 = 1408;
    const int total = n0 + n1 + n2 + n3 + n4;
    for (int it = gw; it < total; it += NGW) {
        int r = it;
        if (r < n0) { if (l < 2) tr_item(a.in[2] + (size_t)l * D * 3 * D, D, 3 * D, ng, 1.f, W1, 2, 0, scr, r, lane);
                      else tr_item(a.in[6], D, 2 * D, a.in[5], 1.f, W1, 0, 0, scr, r, lane); continue; } r -= n0;
        if (r < n1) { tr_item(a.in[7] + (size_t)(l - 2) * D * D, D, D, ng, 0.125f * 1.4426950408889634f, W1, 0, (l == 2) ? 2 * D : 0, scr, r, lane); continue; } r -= n1;
        if (r < n2) { tr_item((l < 2) ? a.in[4] + (size_t)l * D * D : a.in[8] + (size_t)(l - 2) * D * D, D, D, nullptr, 1.f, W3, 0, 0, scr, r, lane); continue; } r -= n2;
        if (r < n3) { tr_item(a.in[9] + (size_t)l * D * 2 * FF, D, 2 * FF, ng + 2 * D, 1.f, WFI, 1, 0, scr, r, lane); continue; } r -= n3;
        tr_item(a.in[10] + (size_t)l * FF * D, FF, D, nullptr, 1.f, WFO, 0, 0, scr, r, lane);
    }
}
__device__ __forceinline__ void unpack8(const v4u w, float (&f)[8]) { f[0] = bflo(w.x); f[1] = bfhi(w.x); f[2] = bflo(w.y); f[3] = bfhi(w.y); f[4] = bflo(w.z); f[5] = bfhi(w.z); f[6] = bflo(w.w); f[7] = bfhi(w.w); }
__device__ __forceinline__ void conv_phase(const bf16* Bg, const bf16* U, const float* wconv, bf16* Aout, int bid, int G, int tid) {
    const int cgp = tid & 127, rc = tid >> 7, c0 = cgp * 8;
    float w0[8], w1[8], w2[8];
#pragma unroll
    for (int e = 0; e < 8; ++e) { w0[e] = wconv[c0 + e]; w1[e] = wconv[D + c0 + e]; w2[e] = wconv[2 * D + c0 + e]; }
    for (int it = bid; it < M / 128; it += G) {
        const int row0 = it * 128 + rc * 32;
        float um2[8], um1[8];
        if ((row0 & (SEQ - 1)) == 0) {
#pragma unroll
            for (int e = 0; e < 8; ++e) { um2[e] = 0.f; um1[e] = 0.f; }
        } else { unpack8(*(const v4u*)(U + (size_t)(row0 - 2) * D + c0), um2); unpack8(*(const v4u*)(U + (size_t)(row0 - 1) * D + c0), um1); }
#pragma unroll 4
        for (int r = 0; r < 32; ++r) {
            float b[8], u[8], o[8];
            unpack8(*(const v4u*)(Bg + (size_t)(row0 + r) * D + c0), b); unpack8(*(const v4u*)(U + (size_t)(row0 + r) * D + c0), u);
#pragma unroll
            for (int e = 0; e < 8; ++e) { o[e] = b[e] * (w0[e] * um2[e] + w1[e] * um1[e] + w2[e] * u[e]); um2[e] = um1[e]; um1[e] = u[e]; }
            v4u w; w.x = pk2(o[0], o[1]); w.y = pk2(o[2], o[3]); w.z = pk2(o[4], o[5]); w.w = pk2(o[6], o[7]);
            *(v4u*)(Aout + (size_t)(row0 + r) * D + c0) = w;
        }
    }
}
typedef short bf16x8 __attribute__((ext_vector_type(8)));
typedef short s16x4 __attribute__((ext_vector_type(4)));
constexpr int KSTR = 144, VSTR = 160, LDS_KOFF = 0, LDS_VOFF = 256 * KSTR, LDS_OSC = 81920;
__device__ __forceinline__ s16x4 vtr(const LAS unsigned char* p) { return __builtin_amdgcn_ds_read_tr16_b64_v4i16((LAS s16x4*)p); }
struct AttBlk { int dl, r, n, g; };
__device__ __forceinline__ AttBlk att_decode(int bi, int sp) { AttBlk k; k.g = bi >> 4; const int j = bi & 15; k.dl = 1 << (2 * k.g);
    k.r = (k.g == 0) ? 0 : (k.g == 1 ? (j >> 2) : j); k.n = (k.g == 0) ? 16 * sp + j : (k.g == 1 ? 4 * sp + (j & 3) : sp); return k; }
__device__ __forceinline__ void att_prefetch(const bf16* Q, const bf16* K, const bf16* V, size_t headoff, int b, int h, int sp, int bi, int skk, int spart, int w, int fr, int fq,
                                             v4u (&pk)[4], v4u (&pv)[4], bf16x8& q0, bf16x8& q1, const bf16* O, const float* LSE, v4u (&op)[2], float& lp) {
    const AttBlk k = att_decode(bi, sp);
    const unsigned char* Kb = (const unsigned char*)(K + headoff); const unsigned char* Vb = (const unsigned char*)(V + headoff);
    const int tok0 = ((k.n - 1) * 128) * k.dl + k.r;
#pragma unroll
    for (int i = 0; i < 4; ++i) { const int kk = skk + 64 * i; int tok = tok0 + kk * k.dl; tok = tok < 0 ? 0 : tok;
        const unsigned off = (unsigned)tok * (HD * 2) + (unsigned)spart * 16u; pk[i] = *(const v4u*)(Kb + off); pv[i] = *(const v4u*)(Vb + off); }
    const unsigned char* Qb = (const unsigned char*)(Q + (size_t)b * SEQ * D + h * HD); const unsigned char* Ob = (const unsigned char*)(O + (size_t)b * SEQ * D + h * HD);
    const float* Lb = LSE + (size_t)(b * NH + h) * SEQ;
    const int t0 = (128 * k.n + 16 * w) * k.dl + k.r;
    const unsigned qt = (unsigned)(t0 + fr * k.dl);
    const unsigned qoff = qt * (D * 2) + (unsigned)fq * 16u;
    q0 = *(const bf16x8*)(Qb + qoff); q1 = *(const bf16x8*)(Qb + qoff + 64);
    lp = Lb[qt];
    const int lane_ = fr + 16 * fq;
#pragma unroll
    for (int i = 0; i < 2; ++i) { const unsigned ot = (unsigned)(t0 + ((lane_ >> 3) + 8 * i) * k.dl); op[i] = *(const v4u*)(Ob + ot * (D * 2) + (unsigned)(lane_ & 7) * 16u); }
}
template <int MODE> __device__ __forceinline__ void att_block(const bf16* Q, const bf16* K, const bf16* V, bf16* O, float* LSE, LAS unsigned char* lds, size_t headoff, float slope2, int b, int h, int sp, int bi,
                                          int skk, int spart, int w, int fr, int fq, v4u (&pk)[4], v4u (&pv)[4], bf16x8& qa, bf16x8& qb, v4u (&opn)[2], float& lpn) {
    const AttBlk k = att_decode(bi, sp);
    const int dl = k.dl, r = k.r, n = k.n, g = k.g;
    asm volatile("s_waitcnt vmcnt(12)" ::: "memory");
    __syncthreads();
    const int uq = 16 * w + fr;
    const size_t qrow = (size_t)b * SEQ + (size_t)(128 * n + uq) * dl + r;
    float lse_prev = lpn; unsigned long long oprev[4];
    LAS unsigned char* osc = lds + LDS_OSC + w * 2304;
    const int lane_ = fr + 16 * fq;
#pragma unroll
    for (int i = 0; i < 2; ++i) *(LAS v4u*)(osc + ((lane_ >> 3) + 8 * i) * 144 + (lane_ & 7) * 16) = opn[i];
#pragma unroll
    for (int dt = 0; dt < 4; ++dt) oprev[dt] = *(const LAS unsigned long long*)(osc + fr * 144 + 32 * dt + 8 * fq);
#pragma unroll
    for (int i = 0; i < 4; ++i) { const int kk = skk + 64 * i; const bool z = (n == 0) && (i < 2);
        const v4u kz = z ? (v4u){0u, 0u, 0u, 0u} : pk[i], vz = z ? (v4u){0u, 0u, 0u, 0u} : pv[i];
        *(LAS v4u*)(lds + LDS_KOFF + kk * KSTR + spart * 16) = kz; *(LAS v4u*)(lds + LDS_VOFF + kk * VSTR + spart * 16) = vz; }
    const bf16x8 q0 = qa, q1 = qb;
    __syncthreads();
    att_prefetch(Q, K, V, headoff, b, h, sp, (bi + 2 < 48) ? bi + 2 : 47, skk, spart, w, fr, fq, pk, pv, qa, qb, O, LSE, opn, lpn);
    float l_run = 0.f; f32x4 oacc[4]; float m_run = 0.f;
#pragma unroll
    for (int dt = 0; dt < 4; ++dt) oacc[dt] = (f32x4){0.f, 0.f, 0.f, 0.f};
    if (MODE & 1) {
    const float bsl = slope2 * (float)dl;
    const float c0 = -bsl * (float)(fr + 128 - 4 * fq); const f32x4 B0 = (f32x4){c0, c0 + bsl, c0 + 2.f * bsl, c0 + 3.f * bsl};
    f32x4 sv[9];
    {
        const LAS unsigned char* kbase = lds + LDS_KOFF + (16 * w + fr) * KSTR + 16 * fq;
        bf16x8 kf[3][2];
#pragma unroll
        for (int bt = 0; bt < 3; ++bt) {
#pragma unroll
            for (int t = 0; t < 3; ++t) { kf[t][0] = *(const LAS bf16x8*)(kbase + (16 * (3 * bt + t)) * KSTR); kf[t][1] = *(const LAS bf16x8*)(kbase + (16 * (3 * bt + t)) * KSTR + 64); }
            __builtin_amdgcn_sched_barrier(0);
#pragma unroll
            for (int t = 0; t < 3; ++t) { f32x4 acc0 = B0;
                acc0 = __builtin_amdgcn_mfma_f32_16x16x32_bf16(kf[t][0], q0, acc0, 0, 0, 0); acc0 = __builtin_amdgcn_mfma_f32_16x16x32_bf16(kf[t][1], q1, acc0, 0, 0, 0);
                sv[3 * bt + t] = acc0; }
            __builtin_amdgcn_sched_barrier(0);
        }
    }
#pragma unroll
    for (int v = 0; v < 4; ++v) { if (4 * fq + v < fr) sv[0][v] = -INFINITY; if (4 * fq + v > fr) sv[8][v] = -INFINITY; }
    float tj[9];
#pragma unroll
    for (int jj = 0; jj < 9; ++jj) tj[jj] = (n == 0 && w + jj < 8) ? -INFINITY : bsl * (float)(16 * jj);
    float mloc = -INFINITY;
#pragma unroll
    for (int jj = 0; jj < 9; ++jj) mloc = fmaxf(mloc, fmaxf(fmaxf(sv[jj][0], sv[jj][1]), fmaxf(sv[jj][2], sv[jj][3])) + tj[jj]);
    mloc = fmaxf(mloc, __shfl_xor(mloc, 16)); mloc = fmaxf(mloc, __shfl_xor(mloc, 32));
    m_run = mloc;
    unsigned pw[10][2];
#pragma unroll
    for (int jj = 0; jj < 9; ++jj) { float pe[4]; const float dj = tj[jj] - mloc;
#pragma unroll
        for (int v = 0; v < 4; ++v) { pe[v] = __builtin_amdgcn_exp2f(sv[jj][v] + dj); l_run += pe[v]; }
        pw[jj][0] = pg8::cvt_pk_bf16(pe[0], pe[1]); pw[jj][1] = pg8::cvt_pk_bf16(pe[2], pe[3]); }
    pw[9][0] = 0u; pw[9][1] = 0u;
    {
        const LAS unsigned char* vbase = lds + LDS_VOFF + (16 * w + 4 * fq + (fr >> 2)) * VSTR + (4 * (fr & 3)) * 2;
        s16x4 vf[4][2], vn[4][2];
#pragma unroll
        for (int dt = 0; dt < 4; ++dt) { vf[dt][0] = vtr(vbase + 32 * dt); vf[dt][1] = vtr(vbase + 32 * dt + 16 * VSTR); }
#pragma unroll
        for (int pp = 0; pp < 5; ++pp) {
            if (pp < 4) {
#pragma unroll
                for (int dt = 0; dt < 4; ++dt) { vn[dt][0] = vtr(vbase + 32 * (pp + 1) * VSTR + 32 * dt); vn[dt][1] = vtr(vbase + 32 * (pp + 1) * VSTR + 32 * dt + 16 * VSTR); }
            }
            __builtin_amdgcn_sched_barrier(0);
            const v4u pq = (v4u){pw[2 * pp][0], pw[2 * pp][1], pw[2 * pp + 1][0], pw[2 * pp + 1][1]};
            const bf16x8 pfrag = __builtin_bit_cast(bf16x8, pq);
#pragma unroll
            for (int dt = 0; dt < 4; ++dt) {
                const bf16x8 af = (bf16x8){vf[dt][0][0], vf[dt][0][1], vf[dt][0][2], vf[dt][0][3], vf[dt][1][0], vf[dt][1][1], vf[dt][1][2], vf[dt][1][3]};
                oacc[dt] = __builtin_amdgcn_mfma_f32_16x16x32_bf16(af, pfrag, oacc[dt], 0, 0, 0);
            }
            __builtin_amdgcn_sched_barrier(0);
            if (pp < 4) {
#pragma unroll
                for (int dt = 0; dt < 4; ++dt) { vf[dt][0] = vn[dt][0]; vf[dt][1] = vn[dt][1]; }
            }
        }
    }
    } else { l_run = 1.f; }
    float l = l_run; l += __shfl_xor(l, 16); l += __shfl_xor(l, 32);
    if (g == 0) { lse_prev = -INFINITY; oprev[0] = 0ull; oprev[1] = 0ull; oprev[2] = 0ull; oprev[3] = 0ull; }
    const float m_tot = fmaxf(lse_prev, m_run), wp = __builtin_amdgcn_exp2f(lse_prev - m_tot), wcur = __builtin_amdgcn_exp2f(m_run - m_tot);
    const float denom = wp + l * wcur, inv = __builtin_amdgcn_rcpf(denom), cp = wp * inv, cc = wcur * inv;
#pragma unroll
    for (int dt = 0; dt < 4; ++dt) { const unsigned lo = (unsigned)oprev[dt], hi = (unsigned)(oprev[dt] >> 32); const f32x4 op = (f32x4){bflo(lo), bfhi(lo), bflo(hi), bfhi(hi)};
        const f32x4 o = op * cp + oacc[dt] * cc; v2u ov; ov.x = pg8::cvt_pk_bf16(o[0], o[1]); ov.y = pg8::cvt_pk_bf16(o[2], o[3]);
        *(LAS v2u*)(osc + fr * 144 + 32 * dt + 8 * fq) = ov; }
#pragma unroll
    for (int i = 0; i < 2; ++i) { const v4u rowv = *(const LAS v4u*)(osc + ((lane_ >> 3) + 8 * i) * 144 + (lane_ & 7) * 16);
        const size_t orow = (size_t)b * SEQ + (size_t)(128 * n + 16 * w + (lane_ >> 3) + 8 * i) * dl + r; *(v4u*)(O + orow * D + h * HD + (lane_ & 7) * 8) = rowv; }
    if (fq == 0) LSE[(size_t)(b * NH + h) * SEQ + (qrow - (size_t)b * SEQ)] = m_tot + __builtin_amdgcn_logf(denom);
}
template <int MODE> __device__ __forceinline__ void attn_fast(const bf16* Q, const bf16* K, const bf16* V, bf16* O, float* LSE, LAS unsigned char* lds, int bid, int G, int tid) {
    const int lane = tid & 63, w = __builtin_amdgcn_readfirstlane(tid >> 6), fr = lane & 15, fq = lane >> 4;
    for (int i = tid; i < 16 * VSTR / 4; i += NT) ((LAS unsigned*)(lds + LDS_VOFF + 256 * VSTR))[i] = 0u;
    const int skk = tid >> 3, spart = tid & 7;
    for (int uid_ = bid; uid_ < 256; uid_ += G) { const int uid = (((uid_ & 7) << 5) | ((uid_ & 255) >> 3));
        const int b = uid >> 6, h = (uid >> 2) & 15, sp = uid & 3;
        const float slope2 = exp2f(-0.5f * (float)(h + 1)) * 1.4426950408889634f;
        const size_t headoff = (size_t)(b * NH + h) * SEQ * HD;
        v4u pkA[4], pvA[4], pkB[4], pvB[4]; bf16x8 qA0, qA1, qB0, qB1; v4u opA[2], opB[2]; float lpA, lpB;
        att_prefetch(Q, K, V, headoff, b, h, sp, 0, skk, spart, w, fr, fq, pkA, pvA, qA0, qA1, O, LSE, opA, lpA);
        att_prefetch(Q, K, V, headoff, b, h, sp, 1, skk, spart, w, fr, fq, pkB, pvB, qB0, qB1, O, LSE, opB, lpB);
#pragma unroll 1
        for (int bi = 0; bi < 48; bi += 2) {
            att_block<MODE>(Q, K, V, O, LSE, lds, headoff, slope2, b, h, sp, bi, skk, spart, w, fr, fq, pkA, pvA, qA0, qA1, opA, lpA);
            att_block<MODE>(Q, K, V, O, LSE, lds, headoff, slope2, b, h, sp, bi + 1, skk, spart, w, fr, fq, pkB, pvB, qB0, qB1, opB, lpB);
        }
        asm volatile("s_waitcnt vmcnt(0)" ::: "memory");
        __syncthreads();
    }
}

#define XB_TMO      128
#define XB_XCNT(j)  (256  + 64 * (j))
#define XB_XSUB(j)  (1280 + 64 * (j))
#define XB_XGEN(j)  (2304 + 64 * (j))
#define XB_TOP      3328
#define XB_TOPGEN   3392
#define XCD_BAR_WORDS 3456
#define XB_SPIN_CAP (1u << 22)
__device__ __forceinline__ unsigned xb_ld(unsigned* p)              { return __hip_atomic_load(p, __ATOMIC_RELAXED, __HIP_MEMORY_SCOPE_AGENT); }
__device__ __forceinline__ unsigned xb_add(unsigned* p, unsigned v) { return __hip_atomic_fetch_add(p, v, __ATOMIC_RELAXED, __HIP_MEMORY_SCOPE_AGENT); }
__device__ __forceinline__ unsigned xb_xcc_id() { return (unsigned)__builtin_amdgcn_s_getreg((3 << 11) | 20) & 0xFu; }
#define XB_SPIN(cond, bar) do { unsigned _sp = 0; while (cond) { __builtin_amdgcn_s_sleep(1); \
    if ((++_sp & 255u) == 0u) { if (xb_ld(&(bar)[XB_TMO])) break; if (_sp > XB_SPIN_CAP) { atomicAdd(&(bar)[XB_TMO], 1u); break; } } } } while (0)
struct XcdBarrier { unsigned* bar; unsigned x; volatile LAS unsigned* st; };
__device__ __forceinline__ XcdBarrier xcd_barrier_post(unsigned* bar, volatile LAS unsigned* st) {
    XcdBarrier b; b.bar = bar; b.x = xb_xcc_id(); b.st = st;
    if (threadIdx.x == 0) (void)xb_add(&bar[XB_XCNT(b.x)], 1u);
    return b;
}
__device__ __forceinline__ void xcd_barrier_complete(unsigned* bar, unsigned x, unsigned& nloc, unsigned& nx) {
    const unsigned G = gridDim.x * gridDim.y * gridDim.z;
    unsigned sum, cnt, mine, sp = 0u;
    for (;;) {
        sum = 0u; cnt = 0u; mine = 0u;
#pragma unroll
        for (unsigned j = 0; j < 16; ++j) { const unsigned c = xb_ld(&bar[XB_XCNT(j)]); sum += c; cnt += (c > 0u) ? 1u : 0u; mine = (j == x) ? c : mine; }
        if (sum == G) break;
        __builtin_amdgcn_s_sleep(1);
        if ((++sp & 255u) == 0u) { if (xb_ld(&bar[XB_TMO])) break; if (sp > XB_SPIN_CAP) { atomicAdd(&bar[XB_TMO], 1u); break; } }
    }
    nloc = mine > 0u ? mine : 1u; nx = cnt > 0u ? cnt : 1u;
}
__device__ __forceinline__ void xcd_barrier(const XcdBarrier& b) {
    asm volatile("s_waitcnt vmcnt(0)" ::: "memory");
    __syncthreads();
    if (threadIdx.x == 0) {
        unsigned* bar = b.bar;
        __builtin_amdgcn_s_waitcnt(0);
        unsigned nloc = b.st[0], nx = b.st[1];
        if (nloc == 0u) { xcd_barrier_complete(bar, b.x, nloc, nx); b.st[0] = nloc; b.st[1] = nx; }
        const unsigned old = xb_add(&bar[XB_XSUB(b.x)], 1u);
        const unsigned gen = old / nloc;
        if (old + 1u == (gen + 1u) * nloc) {
            __builtin_amdgcn_fence(__ATOMIC_RELEASE, "agent");
            asm volatile("s_waitcnt vmcnt(0)" ::: "memory");
            const unsigned og = xb_add(&bar[XB_TOP], 1u);
            const unsigned tg = og / nx;
            if (og + 1u == (tg + 1u) * nx) xb_add(&bar[XB_TOPGEN], 1u);
            else XB_SPIN(xb_ld(&bar[XB_TOPGEN]) == tg, bar);
            __builtin_amdgcn_fence(__ATOMIC_ACQUIRE, "agent");
            xb_add(&bar[XB_XGEN(b.x)], 1u);
            asm volatile("s_waitcnt vmcnt(0)" ::: "memory");
        } else {
            XB_SPIN(xb_ld(&bar[XB_XGEN(b.x)]) == gen, bar);
            __builtin_amdgcn_fence(__ATOMIC_ACQUIRE, "agent");
            asm volatile("s_waitcnt vmcnt(0)" ::: "memory");
        }
    }
    __syncthreads();
}

__global__ void __launch_bounds__(NT, 2) fwd_kernel(Args a) {
    extern __shared__ __attribute__((aligned(16))) unsigned char lds_raw[];
    LAS unsigned char* lds = (LAS unsigned char*)lds_raw;
    cg::grid_group grid = cg::this_grid();
    const int G = gridDim.x, bid = blockIdx.x;
    if (threadIdx.x < 64) ((LAS unsigned*)(lds + 131072))[threadIdx.x] = 0u;
    __syncthreads();
    const XcdBarrier xbar = xcd_barrier_post((unsigned*)(a.ws + WS_CTL) + 4096, (volatile LAS unsigned*)(lds + 131072) + 8);
#define GSYNC() xcd_barrier(xbar)
#define PHASE_VARS() unsigned char* ws = opq(a.ws); float* out = opq(a.out); const int tid = opqv((int)threadIdx.x), lane = tid & 63, wave = __builtin_amdgcn_readfirstlane(tid >> 6); \
    const int gw = bid * NWAVES + wave, NGW = G * NWAVES; bf16* XN = (bf16*)(ws + WS_XN); LAS float* scr = (LAS float*)(lds + wave * 16384); (void)out; (void)lane; (void)gw; (void)NGW; (void)XN; (void)scr;

    {
        PHASE_VARS();
        { v4u* xbz = (v4u*)(ws + WS_XB); for (int i = bid * NT + tid; i < (int)(4 * MiB / 16); i += G * NT) xbz[i] = (v4u){0u, 0u, 0u, 0u}; }
        convert_layer(a, 0, ws + WS_W0, scr, gw, NGW, lane);
        const float* x = opq(a.in[0]);
        for (int m = gw; m < M; m += 2 * NGW) {
            const f32x4* xa = (const f32x4*)(x + (size_t)m * D) + lane; const f32x4* xb = (const f32x4*)(x + (size_t)(m + NGW) * D) + lane;
            f32x4 va[4], vb[4]; float sa = 0.f, sb = 0.f;
#pragma unroll
            for (int j = 0; j < 4; ++j) { va[j] = xa[64 * j]; vb[j] = xb[64 * j]; }
#pragma unroll
            for (int j = 0; j < 4; ++j) { sa += (va[j].x * va[j].x + va[j].y * va[j].y) + (va[j].z * va[j].z + va[j].w * va[j].w); sb += (vb[j].x * vb[j].x + vb[j].y * vb[j].y) + (vb[j].z * vb[j].z + vb[j].w * vb[j].w); }
            const float ra = 1.f / sqrtf(wave_sum(sa) * (1.f / D) + EPS), rb = 1.f / sqrtf(wave_sum(sb) * (1.f / D) + EPS);
            unsigned long long* oa = (unsigned long long*)(XN + (size_t)m * D) + lane; unsigned long long* ob = (unsigned long long*)(XN + (size_t)(m + NGW) * D) + lane;
#pragma unroll
            for (int j = 0; j < 4; ++j) { oa[64 * j] = (unsigned long long)pk2(va[j].x * ra, va[j].y * ra) | ((unsigned long long)pk2(va[j].z * ra, va[j].w * ra) << 32);
                ob[64 * j] = (unsigned long long)pk2(vb[j].x * rb, vb[j].y * rb) | ((unsigned long long)pk2(vb[j].z * rb, vb[j].w * rb) << 32); }
        }
    }
    grid.sync();

#pragma unroll 1
    for (int l = 0; l < DEPTH; ++l) {
        const bool isA = l < 2;
        {
            unsigned char* ws = opq(a.ws); unsigned char* wl = ws + ((l & 1) ? WS_W1 : WS_W0);
            const int N1 = (l == 3) ? D : 3 * D;
            pg8::Gemm g{(const bf16*)(ws + WS_XN), (const bf16*)(wl + WO_1), M, N1, D}; pg8::StaticOrder S; S.init(M, N1, G, bid);
            pg8::EpiBf16 E;
            E.O2 = (bf16*)(ws + WS_KV); E.cmul = isA ? 1 : 0;
            if (isA) { E.O = (bf16*)(ws + WS_G); E.ldc = D; E.split_cols = 0; E.split_stride = 0; E.hm = 0; }
            else if (l == 2) { E.O = (bf16*)(ws + WS_KV); E.ldc = D; E.split_cols = D; E.split_stride = (size_t)M * D; E.hm = 1; }
            else { E.O = (bf16*)(ws + WS_H); E.ldc = D; E.split_cols = 0; E.split_stride = 0; E.hm = 0; }
            pg8::gemm_phase<pg8::EpiBf16, pg8::StaticOrder, true, true>(lds, g, S, E);
        }
        GSYNC();
        {
            PHASE_VARS();
            if (isA) conv_phase((const bf16*)(ws + WS_G), (const bf16*)(ws + WS_KV), opq(a.in[3]) + (size_t)l * 3 * D, (bf16*)(ws + WS_H), bid, G, tid);
            else attn_fast<15>((const bf16*)(ws + WS_H), (const bf16*)(ws + WS_KV), (const bf16*)(ws + WS_KV + 64 * MiB), (bf16*)(ws + WS_H + 64 * MiB), (float*)(ws + WS_LSE), lds, bid, G, tid);
            __syncthreads();
            if (l + 1 < DEPTH) convert_layer(a, l + 1, ws + ((l & 1) ? WS_W0 : WS_W1), scr, gw, NGW, lane);
        }
        GSYNC();
#pragma unroll 1
        for (int round = 0; round < 2; ++round) {
            unsigned char* ws = opq(a.ws); unsigned char* wl = ws + ((l & 1) ? WS_W1 : WS_W0);
            pg8::Gemm g{isA ? (const bf16*)(ws + WS_H) : (const bf16*)(ws + WS_H + 64 * MiB), (const bf16*)(wl + WO_3), M, D, D};
            pg8::RoundOrder S; S.so.init(M, D, G, bid); S.round = round;
            unsigned long long* xb = (unsigned long long*)(ws + WS_XB);
            pg8::EpiRmsResRms E; E.base = (l == 0) ? opq(a.in[0]) : nullptr; E.out = opq(a.out); E.xn = (bf16*)(ws + WS_XN); E.gain = opq(a.in[1]) + (size_t)l * 4 * D + D; E.write_xn = 1; E.write_out = 0;
            E.inv_in = (const float*)(ws + WS_INV) + M; E.inv_out = (float*)(ws + WS_INV);
            E.st1.xbuf = xb; E.st1.tag = (unsigned)(l + 1);
            E.st2.xbuf = xb + (size_t)M * 4; E.st2.tag = (unsigned)(l + 1);
            pg8::gemm_phase<pg8::EpiRmsResRms, pg8::RoundOrder, false, true>(lds, g, S, E);
            __syncthreads();
        }
        GSYNC();
        {
            unsigned char* ws = opq(a.ws); unsigned char* wl = ws + ((l & 1) ? WS_W1 : WS_W0);
            pg8::Gemm g{(const bf16*)(ws + WS_XN), (const bf16*)(wl + WO_FI), M, 2 * FF, D}; pg8::StaticOrder S; S.init(M, 2 * FF, G, bid);
            pg8::EpiSwiGLU E; E.O = (bf16*)(ws + WS_H); E.ldc = FF;
            pg8::gemm_phase<pg8::EpiSwiGLU, pg8::StaticOrder, true, true>(lds, g, S, E);
        }
        GSYNC();
#pragma unroll 1
        for (int round = 0; round < 2; ++round) {
            unsigned char* ws = opq(a.ws); unsigned char* wl = ws + ((l & 1) ? WS_W1 : WS_W0);
            pg8::Gemm g{(const bf16*)(ws + WS_H), (const bf16*)(wl + WO_FO), M, D, FF};
            pg8::RoundOrder S; S.so.init(M, D, G, bid); S.round = round;
            unsigned long long* xb = (unsigned long long*)(ws + WS_XB) + (size_t)M * 8;
            pg8::EpiRmsResRms E; E.base = nullptr; E.out = opq(a.out); E.xn = (bf16*)(ws + WS_XN); E.gain = opq(a.in[1]) + (size_t)l * 4 * D + 3 * D; E.write_xn = (l + 1 < DEPTH) ? 1 : 0; E.write_out = (l + 1 < DEPTH) ? 0 : 1;
            E.inv_in = (const float*)(ws + WS_INV); E.inv_out = (float*)(ws + WS_INV) + M;
            E.st1.xbuf = xb; E.st1.tag = (unsigned)(l + 1);
            E.st2.xbuf = xb + (size_t)M * 4; E.st2.tag = (unsigned)(l + 1);
            pg8::gemm_phase<pg8::EpiRmsResRms, pg8::RoundOrder, false, true>(lds, g, S, E);
            __syncthreads();
        }
        if (l + 1 < DEPTH) GSYNC();
    }
}

extern "C" void kernel_launch(void* const* d_in, const int* in_sizes, int n_in, void* d_out, int out_size, void* d_ws, size_t ws_size, hipStream_t stream) {
    static int grid = 0;
    if (grid == 0) {
        if (n_in != 11 || ws_size < WS_END) { fprintf(stderr, "kernel_launch: unexpected n_in %d / ws_size %zu\n", n_in, ws_size); grid = -1; return; }
        int dev = 0, cus = 0, per_cu = 0;
        hipGetDevice(&dev);
        hipDeviceGetAttribute(&cus, hipDeviceAttributeMultiprocessorCount, dev);
        hipFuncSetAttribute((const void*)fwd_kernel, hipFuncAttributeMaxDynamicSharedMemorySize, LDS_BYTES);
        if (hipOccupancyMaxActiveBlocksPerMultiprocessor(&per_cu, (const void*)fwd_kernel, NT, LDS_BYTES) != hipSuccess || per_cu < 1) per_cu = 1;
        (void)hipGetLastError();
        grid = cus * per_cu;
        if (grid >= 256) grid = 256;
    }
    if (grid < 0) return;
    if (hipMemsetAsync((char*)d_ws + WS_CTL, 0, 64 * 1024, stream) != hipSuccess) { fprintf(stderr, "memset failed\n"); return; }
    Args a{};
    for (int i = 0; i < 11; ++i) a.in[i] = (const float*)d_in[i];
    a.out = (float*)d_out; a.ws = (unsigned char*)d_ws;
    void* args[] = {&a};
    hipError_t e = hipLaunchCooperativeKernel((const void*)fwd_kernel, dim3(grid), dim3(NT), args, LDS_BYTES, stream);
    if (e != hipSuccess) fprintf(stderr, "cooperative launch failed: %s (grid %d)\n", hipGetErrorString(e), grid);
}
```

```cpp
#include <hip/hip_runtime.h>
#include <hip/hip_cooperative_groups.h>
#include <cstdio>
#include <cstdint>
namespace cg = cooperative_groups;

namespace pg8 {
#define PG8_LAS __attribute__((address_space(3)))
typedef unsigned short bf16_t;
typedef short bf16x8 __attribute__((ext_vector_type(8)));
typedef float f32x4 __attribute__((ext_vector_type(4)));
typedef unsigned u32x4 __attribute__((ext_vector_type(4)));
constexpr int BM = 256, BK = 64, HALF = 128, HTB = HALF * BK * 2, STAGE_BYTES = 8 * HTB, NXCD = 8, WGM = 8;

__host__ __device__ __forceinline__ int lds_byte(int r, int c) { const int st = (r >> 4) * 2 + (c >> 5), rr = r & 15, cc = c & 31, ob = rr * 64 + cc * 2; return st * 1024 + (ob ^ (((ob >> 9) & 1) << 5)); }
__host__ __device__ __forceinline__ void stage_rc(int b, int& R, int& C) { const int st = b / 1024, sb = b % 1024, swz = sb ^ (((sb >> 9) & 1) << 5); R = (st >> 1) * 16 + swz / 64; C = (st & 1) * 32 + (swz % 64) / 2; }
__host__ __device__ __forceinline__ int perm32(int rho) { const int n = rho >> 4, i = rho & 15; return 8 * (i >> 2) + 4 * n + (i & 3); }

struct Unit { int pm, pn; };
struct Gemm { const bf16_t* A; const bf16_t* Bt; int M, N, K; };

struct StaticOrder {
    int nM, nN, nwg, G, c;
    __host__ __device__ void init(int M, int N, int G_, int c_) { nM = M / BM; nN = N / BM; nwg = nM * nN; G = G_; c = c_; }
    __host__ __device__ bool next(int i, Unit& u) const { return at(i, u); }
    __host__ __device__ bool at(int i, Unit& u) const {
        const long L = (long)i * G + c; if (L >= nwg) return false;
        int wgid = (int)L; { const int q = nwg / NXCD, r = nwg % NXCD, xcd = wgid % NXCD, off = wgid / NXCD; wgid = (xcd < r ? xcd * (q + 1) : r * (q + 1) + (xcd - r) * q) + off; }
        const int nig = WGM * nN, gid = wgid / nig, fm = gid * WGM, gsz = (nM - fm) < WGM ? (nM - fm) : WGM;
        u.pm = fm + ((wgid % nig) % gsz); u.pn = (wgid % nig) / gsz; return true;
    }
    __device__ __forceinline__ void a_ready(const Unit&) const {}
    __device__ __forceinline__ void done(const Unit&) const {}
};

struct RoundOrder {
    StaticOrder so; int round;
    __device__ __forceinline__ bool next(int i, Unit& u) const { if (i > 0) return false; return so.at(round, u); }
    __device__ __forceinline__ void a_ready(const Unit&) const {}
    __device__ __forceinline__ void done(const Unit&) const {}
};
__device__ __forceinline__ unsigned cvt_pk_bf16(float lo, float hi) { unsigned r; asm volatile("v_cvt_pk_bf16_f32 %0, %1, %2" : "=v"(r) : "v"(lo), "v"(hi)); return r; }

struct EpiBf16 {
    static constexpr bool PERM = true, AFTER_DRAIN = false;
    bf16_t* O; int ldc; int split_cols; size_t split_stride; int hm; bf16_t* O2; int cmul;
    __device__ __forceinline__ void operator()(const f32x4 (&acc)[2][2][4][2], const Unit& u, int wr, int wc, int fr, int fq) const {
        if (cmul && u.pn >= 4) {
            const int row0 = u.pm * BM + wr * 64 + fr, col0 = (u.pn - 4) * HALF + wc * 32 + 8 * fq;
#pragma unroll
            for (int ai = 0; ai < 2; ++ai)
#pragma unroll
                for (int m = 0; m < 4; ++m) { const f32x4 v0 = acc[ai][0][m][0] * acc[ai][1][m][0], v1 = acc[ai][0][m][1] * acc[ai][1][m][1];
                    u32x4 w; w.x = cvt_pk_bf16(v0[0], v0[1]); w.y = cvt_pk_bf16(v0[2], v0[3]); w.z = cvt_pk_bf16(v1[0], v1[1]); w.w = cvt_pk_bf16(v1[2], v1[3]);
                    *(u32x4*)(O2 + (size_t)(row0 + ai * HALF + m * 16) * 1024 + col0) = w; }
            return;
        }
        const int row0 = u.pm * BM + wr * 64 + fr; int colt = u.pn * BM; bf16_t* base = O; int t = 0;
        if (split_cols) { t = colt / split_cols; base += (size_t)t * split_stride; colt -= t * split_cols; }
        const int col0 = colt + wc * 32 + 8 * fq;
        const bool headmajor = hm && t < 2;
#pragma unroll
        for (int ai = 0; ai < 2; ++ai)
#pragma unroll
            for (int m = 0; m < 4; ++m) { const int row = row0 + ai * HALF + m * 16;
                bf16_t* rowp = headmajor ? base + ((size_t)((row >> 13) * 16 + (col0 >> 6)) * 8192 + (row & 8191)) * 64 + (col0 & 63) : base + (size_t)row * ldc + col0;
                const size_t bjstep = headmajor ? (size_t)2 * 8192 * 64 : (size_t)HALF;
#pragma unroll
                for (int bj = 0; bj < 2; ++bj) { const f32x4 v0 = acc[ai][bj][m][0], v1 = acc[ai][bj][m][1];
                    u32x4 w; w.x = cvt_pk_bf16(v0[0], v0[1]); w.y = cvt_pk_bf16(v0[2], v0[3]); w.z = cvt_pk_bf16(v1[0], v1[1]); w.w = cvt_pk_bf16(v1[2], v1[3]);
                    *(u32x4*)(rowp + bj * bjstep) = w; } }
    }
};
__device__ __forceinline__ float silu_mul(float g, float u) { return g * u * __builtin_amdgcn_rcpf(1.0f + __expf(-g)); }
struct EpiSwiGLU {
    static constexpr bool PERM = true, AFTER_DRAIN = false;
    bf16_t* O; int ldc;
    __device__ __forceinline__ void operator()(const f32x4 (&acc)[2][2][4][2], const Unit& u, int wr, int wc, int fr, int fq) const {
        const int row0 = u.pm * BM + wr * 64 + fr; const int col0 = u.pn * HALF + wc * 32 + 8 * fq;
#pragma unroll
        for (int ai = 0; ai < 2; ++ai)
#pragma unroll
            for (int m = 0; m < 4; ++m) { bf16_t* rowp = O + (size_t)(row0 + ai * HALF + m * 16) * ldc + col0;
                const f32x4 g0 = acc[ai][0][m][0], g1 = acc[ai][0][m][1], u0 = acc[ai][1][m][0], u1 = acc[ai][1][m][1];
                u32x4 w; w.x = cvt_pk_bf16(silu_mul(g0[0], u0[0]), silu_mul(g0[1], u0[1])); w.y = cvt_pk_bf16(silu_mul(g0[2], u0[2]), silu_mul(g0[3], u0[3]));
                w.z = cvt_pk_bf16(silu_mul(g1[0], u1[0]), silu_mul(g1[1], u1[1])); w.w = cvt_pk_bf16(silu_mul(g1[2], u1[2]), silu_mul(g1[3], u1[3]));
                *(u32x4*)rowp = w; }
    }
};

struct RmsXchg {
    unsigned long long* xbuf;
    unsigned tag;
    __device__ __forceinline__ void run(const f32x4 (&v)[2][2][4][2], const Unit& u, int wr, int wc, int fr, int fq, PG8_LAS unsigned char* lds, int wid, int lane) const {
        PG8_LAS float* P = (PG8_LAS float*)lds;
        PG8_LAS float* S = (PG8_LAS float*)(lds + 4096);
#pragma unroll
        for (int ai = 0; ai < 2; ++ai)
#pragma unroll
            for (int m = 0; m < 4; ++m) {
                float q = 0.f;
#pragma unroll
                for (int bj = 0; bj < 2; ++bj)
#pragma unroll
                    for (int n = 0; n < 2; ++n) { const f32x4 x = v[ai][bj][m][n]; q += (x[0] * x[0] + x[1] * x[1]) + (x[2] * x[2] + x[3] * x[3]); }
                q += __shfl_xor(q, 16); q += __shfl_xor(q, 32);
                if (fq == 0) P[(ai * HALF + wr * 64 + m * 16 + fr) * 4 + wc] = q;
            }
        asm volatile("s_waitcnt lgkmcnt(0)" ::: "memory"); __builtin_amdgcn_s_barrier(); asm volatile("" ::: "memory");
        const int row = wid * 32 + (lane & 31);
        unsigned long long* slot = xbuf + (size_t)(u.pm * BM + row) * 4;
        if (lane < 32) { const f32x4 p = *(const PG8_LAS f32x4*)(P + row * 4); const float t = (p[0] + p[1]) + (p[2] + p[3]);
            __hip_atomic_store(slot + u.pn, ((unsigned long long)tag << 32) | (unsigned long long)__builtin_bit_cast(unsigned, t), __ATOMIC_RELAXED, __HIP_MEMORY_SCOPE_AGENT); }
        float tot = 0.f; unsigned sp = 0u;
        for (;;) {
            bool ok = true; tot = 0.f;
            if (lane < 32) {
#pragma unroll
                for (int k = 0; k < 4; ++k) { const unsigned long long wv = __hip_atomic_load(slot + k, __ATOMIC_RELAXED, __HIP_MEMORY_SCOPE_AGENT); ok = ok && ((unsigned)(wv >> 32) == tag); tot += __builtin_bit_cast(float, (unsigned)wv); }
            }
            if (__builtin_amdgcn_ballot_w64(!ok) == 0ull) break;
            if (++sp > (1u << 22)) break;
            __builtin_amdgcn_s_sleep(1);
        }
        if (lane < 32) S[row] = 1.0f / sqrtf(tot * (1.0f / 1024.0f) + 1e-6f);
        asm volatile("s_waitcnt lgkmcnt(0)" ::: "memory"); __builtin_amdgcn_s_barrier(); asm volatile("" ::: "memory");
    }
};
struct EpiRmsResRms {
    static constexpr bool PERM = true, AFTER_DRAIN = true;
    const float* base; float* out; bf16_t* xn; const float* gain; const float* inv_in; float* inv_out; RmsXchg st1, st2; int write_xn, write_out;
    __device__ __forceinline__ void fused(f32x4 (&acc)[2][2][4][2], const Unit& u, int wr, int wc, int fr, int fq, PG8_LAS unsigned char* lds, int wid, int lane) const {
        const PG8_LAS float* S = (const PG8_LAS float*)(lds + 4096);
        const int col0 = u.pn * BM + wc * 32 + 8 * fq;
        u32x4 pre[4][2]; float ivs[4], ivs1[4];
        if (!base) {
#pragma unroll
            for (int m = 0; m < 4; ++m) { const int r = wr * 64 + m * 16 + fr; const size_t off = (size_t)(u.pm * BM + r) * 1024 + col0; ivs[m] = inv_in[u.pm * BM + r]; ivs1[m] = inv_in[u.pm * BM + HALF + r];
#pragma unroll
                for (int bj = 0; bj < 2; ++bj) pre[m][bj] = *(const u32x4*)(xn + off + bj * HALF); }
        }
        f32x4 gq[2][2];
#pragma unroll
        for (int bj = 0; bj < 2; ++bj) { gq[bj][0] = *(const f32x4*)(gain + col0 + bj * HALF); gq[bj][1] = *(const f32x4*)(gain + col0 + bj * HALF + 4); }
        st1.run(acc, u, wr, wc, fr, fq, lds, wid, lane);
#pragma unroll
        for (int ai = 0; ai < 2; ++ai)
#pragma unroll
            for (int m = 0; m < 4; ++m) { const int r = ai * HALF + wr * 64 + m * 16 + fr; const float rs = S[r]; const size_t off = (size_t)(u.pm * BM + r) * 1024 + col0;
#pragma unroll
                for (int bj = 0; bj < 2; ++bj) { f32x4 b0, b1;
                    if (base) { b0 = *(const f32x4*)(base + off + bj * HALF); b1 = *(const f32x4*)(base + off + bj * HALF + 4); }
                    else { const u32x4 w = (ai == 0) ? pre[m][bj] : *(const u32x4*)(xn + off + bj * HALF); const float iv = (ai == 0) ? ivs[m] : ivs1[m];
                        b0 = (f32x4){__builtin_bit_cast(float, w.x << 16), __builtin_bit_cast(float, w.x & 0xffff0000u), __builtin_bit_cast(float, w.y << 16), __builtin_bit_cast(float, w.y & 0xffff0000u)} * iv;
                        b1 = (f32x4){__builtin_bit_cast(float, w.z << 16), __builtin_bit_cast(float, w.z & 0xffff0000u), __builtin_bit_cast(float, w.w << 16), __builtin_bit_cast(float, w.w & 0xffff0000u)} * iv; }
                    acc[ai][bj][m][0] = b0 + acc[ai][bj][m][0] * rs * gq[bj][0]; acc[ai][bj][m][1] = b1 + acc[ai][bj][m][1] * rs * gq[bj][1]; }
                asm volatile("" : "+v"(acc[ai][0][m][0]), "+v"(acc[ai][0][m][1]), "+v"(acc[ai][1][m][0]), "+v"(acc[ai][1][m][1])); }
        if (write_xn) st2.run(acc, u, wr, wc, fr, fq, lds, wid, lane);
#pragma unroll
        for (int ai = 0; ai < 2; ++ai)
#pragma unroll
            for (int m = 0; m < 4; ++m) { const int r = ai * HALF + wr * 64 + m * 16 + fr; const float rs = S[r]; const size_t off = (size_t)(u.pm * BM + r) * 1024 + col0;
#pragma unroll
                for (int bj = 0; bj < 2; ++bj) { const f32x4 x0 = acc[ai][bj][m][0], x1 = acc[ai][bj][m][1];
                    if (write_out) { *(f32x4*)(out + off + bj * HALF) = x0; *(f32x4*)(out + off + bj * HALF + 4) = x1; }
                    if (write_xn) { const f32x4 o0 = x0 * rs, o1 = x1 * rs; u32x4 w; w.x = cvt_pk_bf16(o0[0], o0[1]); w.y = cvt_pk_bf16(o0[2], o0[3]); w.z = cvt_pk_bf16(o1[0], o1[1]); w.w = cvt_pk_bf16(o1[2], o1[3]);
                        *(u32x4*)(xn + off + bj * HALF) = w; } }
                asm volatile("" ::: "memory"); }
        if (write_xn && u.pn == 0 && lane < 32) inv_out[u.pm * BM + wid * 32 + lane] = 1.0f / S[wid * 32 + lane];
    }
};

template <class Epi, class Sched, bool ALIGN_EPI = false, bool SP2 = false>
__device__ __forceinline__ void gemm_phase(PG8_LAS unsigned char* lds, const Gemm g, const Sched& S, const Epi& E) {
    int tid = threadIdx.x; asm volatile("" : "+v"(tid));
    const int wid = __builtin_amdgcn_readfirstlane(tid >> 6), lane = tid & 63, wr = wid >> 2, wc = wid & 3, fr = lane & 15, fq = lane >> 4;
    const int K = g.K, nt = K / BK;
    unsigned voffA[2], voffB[2];
#pragma unroll
    for (int i = 0; i < 2; ++i) { int R, C; stage_rc(tid * 16 + i * 8192, R, C); const int Rb = Epi::PERM ? ((R & ~31) + perm32(R & 31)) : R;
        voffA[i] = (unsigned)(R * K + C) * 2u; voffB[i] = (unsigned)(Rb * K + C) * 2u; }
    const size_t kstep = (size_t)(BK * 2);
    const size_t hstep = (size_t)HALF * K * 2;
    const size_t tstep = 2 * hstep;
    const unsigned ldsw = (unsigned)wid * 1024u;
    const int aoff = lds_byte(wr * 64 + fr, fq * 8), boff = lds_byte(wc * 32 + fr, fq * 8);
#define PG8_SA(b, h) (((b) * 2 + (h)) * HTB)
#define PG8_SB(b, h) ((4 + (b) * 2 + (h)) * HTB)
#define PG8_STAGE(bufoff, gbase, voff) do { _Pragma("unroll") for (int _i = 0; _i < 2; ++_i) \
        __builtin_amdgcn_global_load_lds((const unsigned*)((const char*)(gbase) + (voff)[_i]), (PG8_LAS unsigned*)(lds + (bufoff) + ldsw + _i * 8192), 16, 0, 0); } while (0)
#define PG8_LDA(dst, b, h) do { _Pragma("unroll") for (int m = 0; m < 4; ++m) _Pragma("unroll") for (int k = 0; k < 2; ++k) dst[m][k] = *(const PG8_LAS bf16x8*)(lds + PG8_SA(b, h) + aoff + m * 2048 + k * 1024); } while (0)
#define PG8_LDB(dst, b, h) do { _Pragma("unroll") for (int n = 0; n < 2; ++n) _Pragma("unroll") for (int k = 0; k < 2; ++k) dst[n][k] = *(const PG8_LAS bf16x8*)(lds + PG8_SB(b, h) + boff + n * 2048 + k * 1024); } while (0)
#define PG8_MMA(ai, bj, At, Bt) do { __builtin_amdgcn_s_setprio(1); _Pragma("unroll") for (int m = 0; m < 4; ++m) _Pragma("unroll") for (int n = 0; n < 2; ++n) _Pragma("unroll") for (int k = 0; k < 2; ++k) \
        acc[ai][bj][m][n] = __builtin_amdgcn_mfma_f32_16x16x32_bf16(Bt[n][k], At[m][k], acc[ai][bj][m][n], 0, 0, 0); __builtin_amdgcn_s_setprio(0); } while (0)
#define PG8_WAIT_V(n) asm volatile("s_waitcnt vmcnt(" #n ")" ::: "memory")
#define PG8_WAIT_L(n) asm volatile("s_waitcnt lgkmcnt(" #n ")" ::: "memory")
#define PG8_BAR __builtin_amdgcn_s_barrier()
#define PG8_SCHED __builtin_amdgcn_sched_barrier(0)
    Unit cur, nxt; int ui = 0;
    if (!S.next(0, cur)) return;
    f32x4 acc[2][2][4][2];
#pragma unroll
    for (int a = 0; a < 2; ++a)
#pragma unroll
        for (int b = 0; b < 2; ++b)
#pragma unroll
            for (int m = 0; m < 4; ++m)
#pragma unroll
                for (int n = 0; n < 2; ++n) acc[a][b][m][n] = (f32x4){0.f, 0.f, 0.f, 0.f};
    bf16x8 At[4][2], B0[2][2], B1[2][2];
    const char* cA = (const char*)g.A + (size_t)cur.pm * tstep; const char* cB = (const char*)g.Bt + (size_t)cur.pn * tstep;
    S.a_ready(cur);
    if constexpr (SP2) {
        PG8_STAGE(PG8_SB(0, 0), cB, voffB); PG8_STAGE(PG8_SB(0, 1), cB + hstep, voffB); PG8_STAGE(PG8_SA(0, 0), cA, voffA); PG8_STAGE(PG8_SA(0, 1), cA + hstep, voffA);
        if (wr == 1) PG8_BAR;
        PG8_WAIT_V(2); PG8_BAR;
        PG8_STAGE(PG8_SB(1, 0), cB + kstep, voffB); PG8_STAGE(PG8_SA(1, 0), cA + kstep, voffA); PG8_STAGE(PG8_SB(1, 1), cB + hstep + kstep, voffB);
        PG8_WAIT_V(6); PG8_BAR;
    } else {
        PG8_STAGE(PG8_SB(0, 0), cB, voffB); PG8_STAGE(PG8_SA(0, 0), cA, voffA); PG8_STAGE(PG8_SB(0, 1), cB + hstep, voffB); PG8_STAGE(PG8_SA(0, 1), cA + hstep, voffA);
        if (wr == 1) PG8_BAR;
        PG8_WAIT_V(4); PG8_BAR;
        PG8_STAGE(PG8_SB(1, 0), cB + kstep, voffB); PG8_STAGE(PG8_SA(1, 0), cA + kstep, voffA); PG8_STAGE(PG8_SB(1, 1), cB + hstep + kstep, voffB);
        PG8_WAIT_V(6); PG8_BAR;
    }
    for (;;) {
        const bool has_next = S.next(ui + 1, nxt);
        const char* nA = has_next ? (const char*)g.A + (size_t)nxt.pm * tstep : cA; const char* nB = has_next ? (const char*)g.Bt + (size_t)nxt.pn * tstep : cB;
        for (int t = 0; t < nt; t += 2) {
            const bool last = (t == nt - 2);
            const char* a1 = cA + (size_t)(t + 1) * kstep;
            const char* a2 = last ? nA : cA + (size_t)(t + 2) * kstep; const char* b2 = last ? nB : cB + (size_t)(t + 2) * kstep;
            const char* a3 = a2 + kstep; const char* b3 = b2 + kstep;
            if (last && has_next) S.a_ready(nxt);
            if constexpr (SP2) {
            PG8_LDB(B0, 0, 0); PG8_LDB(B1, 0, 1); PG8_SCHED; PG8_LDA(At, 0, 0); PG8_STAGE(PG8_SA(1, 1), a1 + hstep, voffA);
            PG8_WAIT_V(8); PG8_WAIT_L(0); PG8_BAR; PG8_MMA(0, 0, At, B0); PG8_MMA(0, 1, At, B1); PG8_BAR; PG8_SCHED;
            PG8_LDA(At, 0, 1); PG8_STAGE(PG8_SB(0, 0), b2, voffB); PG8_STAGE(PG8_SB(0, 1), b2 + hstep, voffB); PG8_STAGE(PG8_SA(0, 0), a2, voffA);
            PG8_WAIT_V(8); PG8_WAIT_L(0); PG8_BAR; PG8_MMA(1, 0, At, B0); PG8_MMA(1, 1, At, B1); PG8_BAR; PG8_SCHED;
            PG8_LDB(B0, 1, 0); PG8_LDB(B1, 1, 1); PG8_SCHED; PG8_LDA(At, 1, 0); PG8_STAGE(PG8_SA(0, 1), a2 + hstep, voffA);
            PG8_WAIT_V(8); PG8_WAIT_L(0); PG8_BAR; PG8_MMA(0, 0, At, B0); PG8_MMA(0, 1, At, B1); PG8_BAR; PG8_SCHED;
            PG8_LDA(At, 1, 1); PG8_STAGE(PG8_SB(1, 0), b3, voffB); PG8_STAGE(PG8_SB(1, 1), b3 + hstep, voffB); PG8_STAGE(PG8_SA(1, 0), a3, voffA);
            PG8_WAIT_V(8); PG8_WAIT_L(0); PG8_BAR; PG8_MMA(1, 0, At, B0); PG8_MMA(1, 1, At, B1); PG8_BAR; PG8_SCHED;
            } else {
            PG8_LDB(B0, 0, 0); PG8_SCHED; PG8_LDA(At, 0, 0); PG8_STAGE(PG8_SA(1, 1), a1 + hstep, voffA);
            PG8_WAIT_L(8); PG8_BAR; PG8_WAIT_L(0); PG8_MMA(0, 0, At, B0); PG8_BAR; PG8_SCHED;
            PG8_LDB(B1, 0, 1); PG8_STAGE(PG8_SB(0, 0), b2, voffB);
            PG8_BAR; PG8_WAIT_L(0); PG8_MMA(0, 1, At, B1); PG8_BAR;
            PG8_LDA(At, 0, 1); PG8_STAGE(PG8_SA(0, 0), a2, voffA);
            PG8_BAR; PG8_WAIT_L(0); PG8_MMA(1, 0, At, B0); PG8_BAR; PG8_SCHED;
            PG8_STAGE(PG8_SB(0, 1), b2 + hstep, voffB);
            PG8_WAIT_V(6); PG8_BAR; PG8_MMA(1, 1, At, B1); PG8_BAR;
            PG8_LDB(B0, 1, 0); PG8_SCHED; PG8_LDA(At, 1, 0); PG8_STAGE(PG8_SA(0, 1), a2 + hstep, voffA);
            PG8_WAIT_L(8); PG8_BAR; PG8_WAIT_L(0); PG8_MMA(0, 0, At, B0); PG8_BAR; PG8_SCHED;
            PG8_LDB(B1, 1, 1); PG8_STAGE(PG8_SB(1, 0), b3, voffB);
            PG8_BAR; PG8_WAIT_L(0); PG8_MMA(0, 1, At, B1); PG8_BAR;
            PG8_LDA(At, 1, 1); PG8_STAGE(PG8_SA(1, 0), a3, voffA);
            PG8_BAR; PG8_WAIT_L(0); PG8_MMA(1, 0, At, B0); PG8_BAR; PG8_SCHED;
            PG8_STAGE(PG8_SB(1, 1), b3 + hstep, voffB);
            PG8_WAIT_V(6); PG8_BAR; PG8_MMA(1, 1, At, B1); PG8_BAR;
            }
        }
        if constexpr (ALIGN_EPI) { if (wr == 0) PG8_BAR; }
        if constexpr (!Epi::AFTER_DRAIN) { E(acc, cur, wr, wc, fr, fq); S.done(cur); }
        if (!has_next) break;
#pragma unroll
        for (int a = 0; a < 2; ++a)
#pragma unroll
            for (int b = 0; b < 2; ++b)
#pragma unroll
                for (int m = 0; m < 4; ++m)
#pragma unroll
                    for (int n = 0; n < 2; ++n) acc[a][b][m][n] = (f32x4){0.f, 0.f, 0.f, 0.f};
        cur = nxt; cA = nA; cB = nB; ++ui;
        if constexpr (ALIGN_EPI) { if (wr == 1) PG8_BAR; }
    }
    PG8_WAIT_V(0);
    if constexpr (!ALIGN_EPI) { if (wr == 0) PG8_BAR; }
    PG8_BAR;
    if constexpr (Epi::AFTER_DRAIN) { E.fused(acc, cur, wr, wc, fr, fq, lds, wid, lane); S.done(cur); }
#undef PG8_SA
#undef PG8_SB
#undef PG8_STAGE
#undef PG8_LDA
#undef PG8_LDB
#undef PG8_MMA
#undef PG8_WAIT_V
#undef PG8_WAIT_L
#undef PG8_BAR
#undef PG8_SCHED
}
}

#define LAS __attribute__((address_space(3)))
typedef unsigned short bf16;
typedef unsigned v4u __attribute__((ext_vector_type(4)));
typedef unsigned v2u __attribute__((ext_vector_type(2)));
typedef float f32x4 __attribute__((ext_vector_type(4)));
constexpr int NWAVES = 8, NT = 512;
constexpr int BATCH = 4, SEQ = 8192, D = 1024, M = BATCH * SEQ, NH = 16, HD = 64, FF = 2816, DEPTH = 4;
constexpr float EPS = 1e-6f;
constexpr size_t MiB = 1u << 20;
constexpr size_t WS_CTL = 0, WS_LSE = 1 * MiB, WS_W0 = 4 * MiB, WS_W1 = 29 * MiB, WS_XN = 54 * MiB, WS_G = 118 * MiB, WS_KV = 182 * MiB, WS_H = 310 * MiB, WS_XB = 486 * MiB, WS_INV = 490 * MiB, WS_END = 491 * MiB;
constexpr int CW_SEAM = 16384, SEAM_BANK = 128 * 64;
constexpr size_t WO_1 = 0, WO_3 = 6 * MiB, WO_FI = 8 * MiB, WO_FO = 19 * MiB;
constexpr int LDS_BYTES = 131072 + 1024;

struct Args { const float* in[11]; float* out; unsigned char* ws; };

__device__ __forceinline__ unsigned f2bf(float f) { unsigned u = __builtin_bit_cast(unsigned, f); return (u + 0x7fffu + ((u >> 16) & 1u)) >> 16; }
__device__ __forceinline__ unsigned pk2(float lo, float hi) { return f2bf(lo) | (f2bf(hi) << 16); }
__device__ __forceinline__ float bflo(unsigned w) { return __builtin_bit_cast(float, w << 16); }
__device__ __forceinline__ float bfhi(unsigned w) { return __builtin_bit_cast(float, w & 0xffff0000u); }
__device__ __forceinline__ float wave_sum(float v) {
#pragma unroll
    for (int o = 1; o < 64; o <<= 1) v += __shfl_xor(v, o);
    return v;
}
__device__ __forceinline__ float wave_max(float v) {
#pragma unroll
    for (int o = 1; o < 64; o <<= 1) v = fmaxf(v, __shfl_xor(v, o));
    return v;
}
#define LDS_WAIT() asm volatile("s_waitcnt lgkmcnt(0)" ::: "memory")
template <class T> __device__ __forceinline__ T* opq(T* p) { size_t z = 0; asm volatile("" : "+s"(z)); return (T*)((unsigned char*)p + z); }
__device__ __forceinline__ int opqv(int v) { asm volatile("" : "+v"(v)); return v; }

__device__ __forceinline__ void tr_item(const float* W, int K, int N, const float* gain, float scale, bf16* WT, int swiglu, int row_off, LAS float* scr, int item, int lane) {
    const int nblk = N / 32, kb = item / nblk, nb = item % nblk, k0 = 64 * kb, n0 = 32 * nb;
    {
        const int kq = lane >> 3, n4 = (lane & 7) * 4;
        f32x4 wv[8];
#pragma unroll
        for (int i = 0; i < 8; ++i) wv[i] = *(const f32x4*)(W + (size_t)(k0 + 8 * i + kq) * N + n0 + n4);
#pragma unroll
        for (int i = 0; i < 8; ++i) { const int kk = 8 * i + kq; const float gk = gain ? gain[k0 + kk] * scale : scale;
            scr[kk * 33 + n4 + 0] = wv[i][0] * gk; scr[kk * 33 + n4 + 1] = wv[i][1] * gk; scr[kk * 33 + n4 + 2] = wv[i][2] * gk; scr[kk * 33 + n4 + 3] = wv[i][3] * gk; }
    }
    LDS_WAIT(); asm volatile("" ::: "memory");
    int drow0 = n0;
    if (swiglu == 1) drow0 = (n0 < FF) ? ((n0 >> 7) * 256 + (n0 & 127)) : (((n0 - FF) >> 7) * 256 + 128 + ((n0 - FF) & 127));
    if (swiglu == 2) drow0 = (n0 < D) ? n0 : ((n0 < 2 * D) ? (D + ((n0 - D) >> 7) * 256 + ((n0 - D) & 127)) : (D + ((n0 - 2 * D) >> 7) * 256 + 128 + ((n0 - 2 * D) & 127)));
    drow0 += row_off;
    const int c = lane & 7;
#pragma unroll
    for (int j = 0; j < 4; ++j) { const int n = (lane >> 3) + 8 * j; const LAS float* s = scr + (8 * c) * 33 + n;
        v4u o; o.x = pk2(s[0 * 33], s[1 * 33]); o.y = pk2(s[2 * 33], s[3 * 33]); o.z = pk2(s[4 * 33], s[5 * 33]); o.w = pk2(s[6 * 33], s[7 * 33]);
        *(v4u*)(WT + (size_t)(drow0 + n) * K + k0 + 8 * c) = o; }
    LDS_WAIT(); asm volatile("" ::: "memory");
}
__device__ __forceinline__ void convert_layer(const Args& a, int l, unsigned char* wbuf, LAS float* scr, int gw, int NGW, int lane) {
    const float* ng = a.in[1] + (size_t)l * 4 * D;
    bf16* W1 = (bf16*)(wbuf + WO_1); bf16* W3 = (bf16*)(wbuf + WO_3); bf16* WFI = (bf16*)(wbuf + WO_FI); bf16* WFO = (bf16*)(wbuf + WO_FO);
    const int n0 = (l < 2) ? 1536 : (l == 2 ? 1024 : 0), n1 = (l < 2) ? 0 : 512, n2 = 512, n3 = 2816, n4 = 1408;
    const int total = n0 + n1 + n2 + n3 + n4;
    for (int it = gw; it < total; it += NGW) {
        int r = it;
        if (r < n0) { if (l < 2) tr_item(a.in[2] + (size_t)l * D * 3 * D, D, 3 * D, ng, 1.f, W1, 2, 0, scr, r, lane);
                      else tr_item(a.in[6], D, 2 * D, a.in[5], 1.f, W1, 0, 0, scr, r, lane); continue; } r -= n0;
        if (r < n1) { tr_item(a.in[7] + (size_t)(l - 2) * D * D, D, D, ng, 0.125f * 1.4426950408889634f, W1, 0, (l == 2) ? 2 * D : 0, scr, r, lane); continue; } r -= n1;
        if (r < n2) { tr_item((l < 2) ? a.in[4] + (size_t)l * D * D : a.in[8] + (size_t)(l - 2) * D * D, D, D, nullptr, 1.f, W3, 0, 0, scr, r, lane); continue; } r -= n2;
        if (r < n3) { tr_item(a.in[9] + (size_t)l * D * 2 * FF, D, 2 * FF, ng + 2 * D, 1.f, WFI, 1, 0, scr, r, lane); continue; } r -= n3;
        tr_item(a.in[10] + (size_t)l * FF * D, FF, D, nullptr, 1.f, WFO, 0, 0, scr, r, lane);
    }
}
__device__ __forceinline__ void unpack8(const v4u w, float (&f)[8]) { f[0] = bflo(w.x); f[1] = bfhi(w.x); f[2] = bflo(w.y); f[3] = bfhi(w.y); f[4] = bflo(w.z); f[5] = bfhi(w.z); f[6] = bflo(w.w); f[7] = bfhi(w.w); }
__device__ __forceinline__ void conv_phase(const bf16* Bg, const bf16* U, const float* wconv, bf16* Aout, int bid, int G, int tid) {
    const int cgp = tid & 127, rc = tid >> 7, c0 = cgp * 8;
    float w0[8], w1[8], w2[8];
#pragma unroll
    for (int e = 0; e < 8; ++e) { w0[e] = wconv[c0 + e]; w1[e] = wconv[D + c0 + e]; w2[e] = wconv[2 * D + c0 + e]; }
    for (int it = bid; it < M / 128; it += G) {
        const int row0 = it * 128 + rc * 32;
        float um2[8], um1[8];
        if ((row0 & (SEQ - 1)) == 0) {
#pragma unroll
            for (int e = 0; e < 8; ++e) { um2[e] = 0.f; um1[e] = 0.f; }
        } else { unpack8(*(const v4u*)(U + (size_t)(row0 - 2) * D + c0), um2); unpack8(*(const v4u*)(U + (size_t)(row0 - 1) * D + c0), um1); }
#pragma unroll 4
        for (int r = 0; r < 32; ++r) {
            float b[8], u[8], o[8];
            unpack8(*(const v4u*)(Bg + (size_t)(row0 + r) * D + c0), b); unpack8(*(const v4u*)(U + (size_t)(row0 + r) * D + c0), u);
#pragma unroll
            for (int e = 0; e < 8; ++e) { o[e] = b[e] * (w0[e] * um2[e] + w1[e] * um1[e] + w2[e] * u[e]); um2[e] = um1[e]; um1[e] = u[e]; }
            v4u w; w.x = pk2(o[0], o[1]); w.y = pk2(o[2], o[3]); w.z = pk2(o[4], o[5]); w.w = pk2(o[6], o[7]);
            *(v4u*)(Aout + (size_t)(row0 + r) * D + c0) = w;
        }
    }
}
typedef short bf16x8 __attribute__((ext_vector_type(8)));
typedef short s16x4 __attribute__((ext_vector_type(4)));
constexpr int KSTR = 144, VSTR = 160, LDS_KOFF = 0, LDS_VOFF = 256 * KSTR, LDS_OSC = 81920;
__device__ __forceinline__ s16x4 vtr(const LAS unsigned char* p) { return __builtin_amdgcn_ds_read_tr16_b64_v4i16((LAS s16x4*)p); }
struct AttBlk { int dl, r, n, g; };
__device__ __forceinline__ AttBlk att_decode(int bi, int sp) { AttBlk k; k.g = bi >> 4; const int j = bi & 15; k.dl = 1 << (2 * k.g);
    k.r = (k.g == 0) ? 0 : (k.g == 1 ? (j >> 2) : j); k.n = (k.g == 0) ? 16 * sp + j : (k.g == 1 ? 4 * sp + (j & 3) : sp); return k; }
__device__ __forceinline__ void att_prefetch(const bf16* Q, const bf16* K, const bf16* V, size_t headoff, int b, int h, int sp, int bi, int skk, int spart, int w, int fr, int fq,
                                             v4u (&pk)[4], v4u (&pv)[4], bf16x8& q0, bf16x8& q1, const bf16* O, const float* LSE, v4u (&op)[2], float& lp) {
    const AttBlk k = att_decode(bi, sp);
    const unsigned char* Kb = (const unsigned char*)(K + headoff); const unsigned char* Vb = (const unsigned char*)(V + headoff);
    const int tok0 = ((k.n - 1) * 128) * k.dl + k.r;
#pragma unroll
    for (int i = 0; i < 4; ++i) { const int kk = skk + 64 * i; int tok = tok0 + kk * k.dl; tok = tok < 0 ? 0 : tok;
        const unsigned off = (unsigned)tok * (HD * 2) + (unsigned)spart * 16u; pk[i] = *(const v4u*)(Kb + off); pv[i] = *(const v4u*)(Vb + off); }
    const unsigned char* Qb = (const unsigned char*)(Q + (size_t)b * SEQ * D + h * HD); const unsigned char* Ob = (const unsigned char*)(O + (size_t)b * SEQ * D + h * HD);
    const float* Lb = LSE + (size_t)(b * NH + h) * SEQ;
    const int t0 = (128 * k.n + 16 * w) * k.dl + k.r;
    const unsigned qt = (unsigned)(t0 + fr * k.dl);
    const unsigned qoff = qt * (D * 2) + (unsigned)fq * 16u;
    q0 = *(const bf16x8*)(Qb + qoff); q1 = *(const bf16x8*)(Qb + qoff + 64);
    lp = Lb[qt];
    const int lane_ = fr + 16 * fq;
#pragma unroll
    for (int i = 0; i < 2; ++i) { const unsigned ot = (unsigned)(t0 + ((lane_ >> 3) + 8 * i) * k.dl); op[i] = *(const v4u*)(Ob + ot * (D * 2) + (unsigned)(lane_ & 7) * 16u); }
}
template <int MODE> __device__ __forceinline__ void att_block(const bf16* Q, const bf16* K, const bf16* V, bf16* O, float* LSE, LAS unsigned char* lds, size_t headoff, float slope2, int b, int h, int sp, int bi,
                                          int skk, int spart, int w, int fr, int fq, v4u (&pk)[4], v4u (&pv)[4], bf16x8& qa, bf16x8& qb, v4u (&opn)[2], float& lpn) {
    const AttBlk k = att_decode(bi, sp);
    const int dl = k.dl, r = k.r, n = k.n, g = k.g;
    asm volatile("s_waitcnt vmcnt(12)" ::: "memory");
    __syncthreads();
    const int uq = 16 * w + fr;
    const size_t qrow = (size_t)b * SEQ + (size_t)(128 * n + uq) * dl + r;
    float lse_prev = lpn; unsigned long long oprev[4];
    LAS unsigned char* osc = lds + LDS_OSC + w * 2304;
    const int lane_ = fr + 16 * fq;
#pragma unroll
    for (int i = 0; i < 2; ++i) *(LAS v4u*)(osc + ((lane_ >> 3) + 8 * i) * 144 + (lane_ & 7) * 16) = opn[i];
#pragma unroll
    for (int dt = 0; dt < 4; ++dt) oprev[dt] = *(const LAS unsigned long long*)(osc + fr * 144 + 32 * dt + 8 * fq);
#pragma unroll
    for (int i = 0; i < 4; ++i) { const int kk = skk + 64 * i; const bool z = (n == 0) && (i < 2);
        const v4u kz = z ? (v4u){0u, 0u, 0u, 0u} : pk[i], vz = z ? (v4u){0u, 0u, 0u, 0u} : pv[i];
        *(LAS v4u*)(lds + LDS_KOFF + kk * KSTR + spart * 16) = kz; *(LAS v4u*)(lds + LDS_VOFF + kk * VSTR + spart * 16) = vz; }
    const bf16x8 q0 = qa, q1 = qb;
    __syncthreads();
    att_prefetch(Q, K, V, headoff, b, h, sp, (bi + 2 < 48) ? bi + 2 : 47, skk, spart, w, fr, fq, pk, pv, qa, qb, O, LSE, opn, lpn);
    float l_run = 0.f; f32x4 oacc[4]; float m_run = 0.f;
#pragma unroll
    for (int dt = 0; dt < 4; ++dt) oacc[dt] = (f32x4){0.f, 0.f, 0.f, 0.f};
    if (MODE & 1) {
    const float bsl = slope2 * (float)dl;
    const float c0 = -bsl * (float)(fr + 128 - 4 * fq); const f32x4 B0 = (f32x4){c0, c0 + bsl, c0 + 2.f * bsl, c0 + 3.f * bsl};
    f32x4 sv[9];
    {
        const LAS unsigned char* kbase = lds + LDS_KOFF + (16 * w + fr) * KSTR + 16 * fq;
        bf16x8 kf[3][2];
#pragma unroll
        for (int bt = 0; bt < 3; ++bt) {
#pragma unroll
            for (int t = 0; t < 3; ++t) { kf[t][0] = *(const LAS bf16x8*)(kbase + (16 * (3 * bt + t)) * KSTR); kf[t][1] = *(const LAS bf16x8*)(kbase + (16 * (3 * bt + t)) * KSTR + 64); }
            __builtin_amdgcn_sched_barrier(0);
#pragma unroll
            for (int t = 0; t < 3; ++t) { f32x4 acc0 = B0;
                acc0 = __builtin_amdgcn_mfma_f32_16x16x32_bf16(kf[t][0], q0, acc0, 0, 0, 0); acc0 = __builtin_amdgcn_mfma_f32_16x16x32_bf16(kf[t][1], q1, acc0, 0, 0, 0);
                sv[3 * bt + t] = acc0; }
            __builtin_amdgcn_sched_barrier(0);
        }
    }
#pragma unroll
    for (int v = 0; v < 4; ++v) { if (4 * fq + v < fr) sv[0][v] = -INFINITY; if (4 * fq + v > fr) sv[8][v] = -INFINITY; }
    float tj[9];
#pragma unroll
    for (int jj = 0; jj < 9; ++jj) tj[jj] = (n == 0 && w + jj < 8) ? -INFINITY : bsl * (float)(16 * jj);
    float mloc = -INFINITY;
#pragma unroll
    for (int jj = 0; jj < 9; ++jj) mloc = fmaxf(mloc, fmaxf(fmaxf(sv[jj][0], sv[jj][1]), fmaxf(sv[jj][2], sv[jj][3])) + tj[jj]);
    mloc = fmaxf(mloc, __shfl_xor(mloc, 16)); mloc = fmaxf(mloc, __shfl_xor(mloc, 32));
    m_run = mloc;
    unsigned pw[10][2];
#pragma unroll
    for (int jj = 0; jj < 9; ++jj) { float pe[4]; const float dj = tj[jj] - mloc;
#pragma unroll
        for (int v = 0; v < 4; ++v) { pe[v] = __builtin_amdgcn_exp2f(sv[jj][v] + dj); l_run += pe[v]; }
        pw[jj][0] = pg8::cvt_pk_bf16(pe[0], pe[1]); pw[jj][1] = pg8::cvt_pk_bf16(pe[2], pe[3]); }
    pw[9][0] = 0u; pw[9][1] = 0u;
    {
        const LAS unsigned char* vbase = lds + LDS_VOFF + (16 * w + 4 * fq + (fr >> 2)) * VSTR + (4 * (fr & 3)) * 2;
        s16x4 vf[4][2], vn[4][2];
#pragma unroll
        for (int dt = 0; dt < 4; ++dt) { vf[dt][0] = vtr(vbase + 32 * dt); vf[dt][1] = vtr(vbase + 32 * dt + 16 * VSTR); }
#pragma unroll
        for (int pp = 0; pp < 5; ++pp) {
            if (pp < 4) {
#pragma unroll
                for (int dt = 0; dt < 4; ++dt) { vn[dt][0] = vtr(vbase + 32 * (pp + 1) * VSTR + 32 * dt); vn[dt][1] = vtr(vbase + 32 * (pp + 1) * VSTR + 32 * dt + 16 * VSTR); }
            }
            __builtin_amdgcn_sched_barrier(0);
            const v4u pq = (v4u){pw[2 * pp][0], pw[2 * pp][1], pw[2 * pp + 1][0], pw[2 * pp + 1][1]};
            const bf16x8 pfrag = __builtin_bit_cast(bf16x8, pq);
#pragma unroll
            for (int dt = 0; dt < 4; ++dt) {
                const bf16x8 af = (bf16x8){vf[dt][0][0], vf[dt][0][1], vf[dt][0][2], vf[dt][0][3], vf[dt][1][0], vf[dt][1][1], vf[dt][1][2], vf[dt][1][3]};
                oacc[dt] = __builtin_amdgcn_mfma_f32_16x16x32_bf16(af, pfrag, oacc[dt], 0, 0, 0);
            }
            __builtin_amdgcn_sched_barrier(0);
            if (pp < 4) {
#pragma unroll
                for (int dt = 0; dt < 4; ++dt) { vf[dt][0] = vn[dt][0]; vf[dt][1] = vn[dt][1]; }
            }
        }
    }
    } else { l_run = 1.f; }
    float l = l_run; l += __shfl_xor(l, 16); l += __shfl_xor(l, 32);
    if (g == 0) { lse_prev = -INFINITY; oprev[0] = 0ull; oprev[1] = 0ull; oprev[2] = 0ull; oprev[3] = 0ull; }
    const float m_tot = fmaxf(lse_prev, m_run), wp = __builtin_amdgcn_exp2f(lse_prev - m_tot), wcur = __builtin_amdgcn_exp2f(m_run - m_tot);
    const float denom = wp + l * wcur, inv = __builtin_amdgcn_rcpf(denom), cp = wp * inv, cc = wcur * inv;
#pragma unroll
    for (int dt = 0; dt < 4; ++dt) { const unsigned lo = (unsigned)oprev[dt], hi = (unsigned)(oprev[dt] >> 32); const f32x4 op = (f32x4){bflo(lo), bfhi(lo), bflo(hi), bfhi(hi)};
        const f32x4 o = op * cp + oacc[dt] * cc; v2u ov; ov.x = pg8::cvt_pk_bf16(o[0], o[1]); ov.y = pg8::cvt_pk_bf16(o[2], o[3]);
        *(LAS v2u*)(osc + fr * 144 + 32 * dt + 8 * fq) = ov; }
#pragma unroll
    for (int i = 0; i < 2; ++i) { const v4u rowv = *(const LAS v4u*)(osc + ((lane_ >> 3) + 8 * i) * 144 + (lane_ & 7) * 16);
        const size_t orow = (size_t)b * SEQ + (size_t)(128 * n + 16 * w + (lane_ >> 3) + 8 * i) * dl + r; *(v4u*)(O + orow * D + h * HD + (lane_ & 7) * 8) = rowv; }
    if (fq == 0) LSE[(size_t)(b * NH + h) * SEQ + (qrow - (size_t)b * SEQ)] = m_tot + __builtin_amdgcn_logf(denom);
}
template <int MODE> __device__ __forceinline__ void attn_fast(const bf16* Q, const bf16* K, const bf16* V, bf16* O, float* LSE, LAS unsigned char* lds, int bid, int G, int tid) {
    const int lane = tid & 63, w = __builtin_amdgcn_readfirstlane(tid >> 6), fr = lane & 15, fq = lane >> 4;
    for (int i = tid; i < 16 * VSTR / 4; i += NT) ((LAS unsigned*)(lds + LDS_VOFF + 256 * VSTR))[i] = 0u;
    const int skk = tid >> 3, spart = tid & 7;
    for (int uid_ = bid; uid_ < 256; uid_ += G) { const int uid = (((uid_ & 7) << 5) | ((uid_ & 255) >> 3));
        const int b = uid >> 6, h = (uid >> 2) & 15, sp = uid & 3;
        const float slope2 = exp2f(-0.5f * (float)(h + 1)) * 1.4426950408889634f;
        const size_t headoff = (size_t)(b * NH + h) * SEQ * HD;
        v4u pkA[4], pvA[4], pkB[4], pvB[4]; bf16x8 qA0, qA1, qB0, qB1; v4u opA[2], opB[2]; float lpA, lpB;
        att_prefetch(Q, K, V, headoff, b, h, sp, 0, skk, spart, w, fr, fq, pkA, pvA, qA0, qA1, O, LSE, opA, lpA);
        att_prefetch(Q, K, V, headoff, b, h, sp, 1, skk, spart, w, fr, fq, pkB, pvB, qB0, qB1, O, LSE, opB, lpB);
#pragma unroll 1
        for (int bi = 0; bi < 48; bi += 2) {
            att_block<MODE>(Q, K, V, O, LSE, lds, headoff, slope2, b, h, sp, bi, skk, spart, w, fr, fq, pkA, pvA, qA0, qA1, opA, lpA);
            att_block<MODE>(Q, K, V, O, LSE, lds, headoff, slope2, b, h, sp, bi + 1, skk, spart, w, fr, fq, pkB, pvB, qB0, qB1, opB, lpB);
        }
        asm volatile("s_waitcnt vmcnt(0)" ::: "memory");
        __syncthreads();
    }
}

#define XB_TMO      128
#define XB_XCNT(j)  (256  + 64 * (j))
#define XB_XSUB(j)  (1280 + 64 * (j))
#define XB_XGEN(j)  (2304 + 64 * (j))
#define XB_TOP      3328
#define XB_TOPGEN   3392
#define XCD_BAR_WORDS 3456
#define XB_SPIN_CAP (1u << 22)
__device__ __forceinline__ unsigned xb_ld(unsigned* p)              { return __hip_atomic_load(p, __ATOMIC_RELAXED, __HIP_MEMORY_SCOPE_AGENT); }
__device__ __forceinline__ unsigned xb_add(unsigned* p, unsigned v) { return __hip_atomic_fetch_add(p, v, __ATOMIC_RELAXED, __HIP_MEMORY_SCOPE_AGENT); }
__device__ __forceinline__ unsigned xb_xcc_id() { return (unsigned)__builtin_amdgcn_s_getreg((3 << 11) | 20) & 0xFu; }
#define XB_SPIN(cond, bar) do { unsigned _sp = 0; while (cond) { __builtin_amdgcn_s_sleep(1); \
    if ((++_sp & 255u) == 0u) { if (xb_ld(&(bar)[XB_TMO])) break; if (_sp > XB_SPIN_CAP) { atomicAdd(&(bar)[XB_TMO], 1u); break; } } } } while (0)
struct XcdBarrier { unsigned* bar; unsigned x; volatile LAS unsigned* st; };
__device__ __forceinline__ XcdBarrier xcd_barrier_post(unsigned* bar, volatile LAS unsigned* st) {
    XcdBarrier b; b.bar = bar; b.x = xb_xcc_id(); b.st = st;
    if (threadIdx.x == 0) (void)xb_add(&bar[XB_XCNT(b.x)], 1u);
    return b;
}
__device__ __forceinline__ void xcd_barrier_complete(unsigned* bar, unsigned x, unsigned& nloc, unsigned& nx) {
    const unsigned G = gridDim.x * gridDim.y * gridDim.z;
    unsigned sum, cnt, mine, sp = 0u;
    for (;;) {
        sum = 0u; cnt = 0u; mine = 0u;
#pragma unroll
        for (unsigned j = 0; j < 16; ++j) { const unsigned c = xb_ld(&bar[XB_XCNT(j)]); sum += c; cnt += (c > 0u) ? 1u : 0u; mine = (j == x) ? c : mine; }
        if (sum == G) break;
        __builtin_amdgcn_s_sleep(1);
        if ((++sp & 255u) == 0u) { if (xb_ld(&bar[XB_TMO])) break; if (sp > XB_SPIN_CAP) { atomicAdd(&bar[XB_TMO], 1u); break; } }
    }
    nloc = mine > 0u ? mine : 1u; nx = cnt > 0u ? cnt : 1u;
}
__device__ __forceinline__ void xcd_barrier(const XcdBarrier& b) {
    asm volatile("s_waitcnt vmcnt(0)" ::: "memory");
    __syncthreads();
    if (threadIdx.x == 0) {
        unsigned* bar = b.bar;
        __builtin_amdgcn_s_waitcnt(0);
        unsigned nloc = b.st[0], nx = b.st[1];
        if (nloc == 0u) { xcd_barrier_complete(bar, b.x, nloc, nx); b.st[0] = nloc; b.st[1] = nx; }
        const unsigned old = xb_add(&bar[XB_XSUB(b.x)], 1u);
        const unsigned gen = old / nloc;
        if (old + 1u == (gen + 1u) * nloc) {
            __builtin_amdgcn_fence(__ATOMIC_RELEASE, "agent");
            asm volatile("s_waitcnt vmcnt(0)" ::: "memory");
            const unsigned og = xb_add(&bar[XB_TOP], 1u);
            const unsigned tg = og / nx;
            if (og + 1u == (tg + 1u) * nx) xb_add(&bar[XB_TOPGEN], 1u);
            else XB_SPIN(xb_ld(&bar[XB_TOPGEN]) == tg, bar);
            __builtin_amdgcn_fence(__ATOMIC_ACQUIRE, "agent");
            xb_add(&bar[XB_XGEN(b.x)], 1u);
            asm volatile("s_waitcnt vmcnt(0)" ::: "memory");
        } else {
            XB_SPIN(xb_ld(&bar[XB_XGEN(b.x)]) == gen, bar);
            __builtin_amdgcn_fence(__ATOMIC_ACQUIRE, "agent");
            asm volatile("s_waitcnt vmcnt(0)" ::: "memory");
        }
    }
    __syncthreads();
}

__global__ void __launch_bounds__(NT, 2) fwd_kernel(Args a) {
    extern __shared__ __attribute__((aligned(16))) unsigned char lds_raw[];
    LAS unsigned char* lds = (LAS unsigned char*)lds_raw;
    cg::grid_group grid = cg::this_grid();
    const int G = gridDim.x, bid = blockIdx.x;
    if (threadIdx.x < 64) ((LAS unsigned*)(lds + 131072))[threadIdx.x] = 0u;
    __syncthreads();
    const XcdBarrier xbar = xcd_barrier_post((unsigned*)(a.ws + WS_CTL) + 4096, (volatile LAS unsigned*)(lds + 131072) + 8);
#define GSYNC() xcd_barrier(xbar)
#define PHASE_VARS() unsigned char* ws = opq(a.ws); float* out = opq(a.out); const int tid = opqv((int)threadIdx.x), lane = tid & 63, wave = __builtin_amdgcn_readfirstlane(tid >> 6); \
    const int gw = bid * NWAVES + wave, NGW = G * NWAVES; bf16* XN = (bf16*)(ws + WS_XN); LAS float* scr = (LAS float*)(lds + wave * 16384); (void)out; (void)lane; (void)gw; (void)NGW; (void)XN; (void)scr;

    {
        PHASE_VARS();
        { v4u* xbz = (v4u*)(ws + WS_XB); for (int i = bid * NT + tid; i < (int)(4 * MiB / 16); i += G * NT) xbz[i] = (v4u){0u, 0u, 0u, 0u}; }
        convert_layer(a, 0, ws + WS_W0, scr, gw, NGW, lane);
        const float* x = opq(a.in[0]);
        for (int m = gw; m < M; m += 2 * NGW) {
            const f32x4* xa = (const f32x4*)(x + (size_t)m * D) + lane; const f32x4* xb = (const f32x4*)(x + (size_t)(m + NGW) * D) + lane;
            f32x4 va[4], vb[4]; float sa = 0.f, sb = 0.f;
#pragma unroll
            for (int j = 0; j < 4; ++j) { va[j] = xa[64 * j]; vb[j] = xb[64 * j]; }
#pragma unroll
            for (int j = 0; j < 4; ++j) { sa += (va[j].x * va[j].x + va[j].y * va[j].y) + (va[j].z * va[j].z + va[j].w * va[j].w); sb += (vb[j].x * vb[j].x + vb[j].y * vb[j].y) + (vb[j].z * vb[j].z + vb[j].w * vb[j].w); }
            const float ra = 1.f / sqrtf(wave_sum(sa) * (1.f / D) + EPS), rb = 1.f / sqrtf(wave_sum(sb) * (1.f / D) + EPS);
            unsigned long long* oa = (unsigned long long*)(XN + (size_t)m * D) + lane; unsigned long long* ob = (unsigned long long*)(XN + (size_t)(m + NGW) * D) + lane;
#pragma unroll
            for (int j = 0; j < 4; ++j) { oa[64 * j] = (unsigned long long)pk2(va[j].x * ra, va[j].y * ra) | ((unsigned long long)pk2(va[j].z * ra, va[j].w * ra) << 32);
                ob[64 * j] = (unsigned long long)pk2(vb[j].x * rb, vb[j].y * rb) | ((unsigned long long)pk2(vb[j].z * rb, vb[j].w * rb) << 32); }
        }
    }
    grid.sync();

#pragma unroll 1
    for (int l = 0; l < DEPTH; ++l) {
        const bool isA = l < 2;
        {
            unsigned char* ws = opq(a.ws); unsigned char* wl = ws + ((l & 1) ? WS_W1 : WS_W0);
            const int N1 = (l == 3) ? D : 3 * D;
            pg8::Gemm g{(const bf16*)(ws + WS_XN), (const bf16*)(wl + WO_1), M, N1, D}; pg8::StaticOrder S; S.init(M, N1, G, bid);
            pg8::EpiBf16 E;
            E.O2 = (bf16*)(ws + WS_KV); E.cmul = isA ? 1 : 0;
            if (isA) { E.O = (bf16*)(ws + WS_G); E.ldc = D; E.split_cols = 0; E.split_stride = 0; E.hm = 0; }
            else if (l == 2) { E.O = (bf16*)(ws + WS_KV); E.ldc = D; E.split_cols = D; E.split_stride = (size_t)M * D; E.hm = 1; }
            else { E.O = (bf16*)(ws + WS_H); E.ldc = D; E.split_cols = 0; E.split_stride = 0; E.hm = 0; }
            pg8::gemm_phase<pg8::EpiBf16, pg8::StaticOrder, true, true>(lds, g, S, E);
        }
        GSYNC();
        {
            PHASE_VARS();
            if (isA) conv_phase((const bf16*)(ws + WS_G), (const bf16*)(ws + WS_KV), opq(a.in[3]) + (size_t)l * 3 * D, (bf16*)(ws + WS_H), bid, G, tid);
            else attn_fast<15>((const bf16*)(ws + WS_H), (const bf16*)(ws + WS_KV), (const bf16*)(ws + WS_KV + 64 * MiB), (bf16*)(ws + WS_H + 64 * MiB), (float*)(ws + WS_LSE), lds, bid, G, tid);
            __syncthreads();
            if (l + 1 < DEPTH) convert_layer(a, l + 1, ws + ((l & 1) ? WS_W0 : WS_W1), scr, gw, NGW, lane);
        }
        GSYNC();
#pragma unroll 1
        for (int round = 0; round < 2; ++round) {
            unsigned char* ws = opq(a.ws); unsigned char* wl = ws + ((l & 1) ? WS_W1 : WS_W0);
            pg8::Gemm g{isA ? (const bf16*)(ws + WS_H) : (const bf16*)(ws + WS_H + 64 * MiB), (const bf16*)(wl + WO_3), M, D, D};
            pg8::RoundOrder S; S.so.init(M, D, G, bid); S.round = round;
            unsigned long long* xb = (unsigned long long*)(ws + WS_XB);
            pg8::EpiRmsResRms E; E.base = (l == 0) ? opq(a.in[0]) : nullptr; E.out = opq(a.out); E.xn = (bf16*)(ws + WS_XN); E.gain = opq(a.in[1]) + (size_t)l * 4 * D + D; E.write_xn = 1; E.write_out = 0;
            E.inv_in = (const float*)(ws + WS_INV) + M; E.inv_out = (float*)(ws + WS_INV);
            E.st1.xbuf = xb; E.st1.tag = (unsigned)(l + 1);
            E.st2.xbuf = xb + (size_t)M * 4; E.st2.tag = (unsigned)(l + 1);
            pg8::gemm_phase<pg8::EpiRmsResRms, pg8::RoundOrder, false, true>(lds, g, S, E);
            __syncthreads();
        }
        GSYNC();
        {
            unsigned char* ws = opq(a.ws); unsigned char* wl = ws + ((l & 1) ? WS_W1 : WS_W0);
            pg8::Gemm g{(const bf16*)(ws + WS_XN), (const bf16*)(wl + WO_FI), M, 2 * FF, D}; pg8::StaticOrder S; S.init(M, 2 * FF, G, bid);
            pg8::EpiSwiGLU E; E.O = (bf16*)(ws + WS_H); E.ldc = FF;
            pg8::gemm_phase<pg8::EpiSwiGLU, pg8::StaticOrder, true, true>(lds, g, S, E);
        }
        GSYNC();
#pragma unroll 1
        for (int round = 0; round < 2; ++round) {
            unsigned char* ws = opq(a.ws); unsigned char* wl = ws + ((l & 1) ? WS_W1 : WS_W0);
            pg8::Gemm g{(const bf16*)(ws + WS_H), (const bf16*)(wl + WO_FO), M, D, FF};
            pg8::RoundOrder S; S.so.init(M, D, G, bid); S.round = round;
            unsigned long long* xb = (unsigned long long*)(ws + WS_XB) + (size_t)M * 8;
            pg8::EpiRmsResRms E; E.base = nullptr; E.out = opq(a.out); E.xn = (bf16*)(ws + WS_XN); E.gain = opq(a.in[1]) + (size_t)l * 4 * D + 3 * D; E.write_xn = (l + 1 < DEPTH) ? 1 : 0; E.write_out = (l + 1 < DEPTH) ? 0 : 1;
            E.inv_in = (const float*)(ws + WS_INV); E.inv_out = (float*)(ws + WS_INV) + M;
            E.st1.xbuf = xb; E.st1.tag = (unsigned)(l + 1);
            E.st2.xbuf = xb + (size_t)M * 4; E.st2.tag = (unsigned)(l + 1);
            pg8::gemm_phase<pg8::EpiRmsResRms, pg8::RoundOrder, false, true>(lds, g, S, E);
            __syncthreads();
        }
        if (l + 1 < DEPTH) GSYNC();
    }
}

extern "C" void kernel_launch(void* const* d_in, const int* in_sizes, int n_in, void* d_out, int out_size, void* d_ws, size_t ws_size, hipStream_t stream) {
    static int grid = 0;
    if (grid == 0) {
        if (n_in != 11 || ws_size < WS_END) { fprintf(stderr, "kernel_launch: unexpected n_in %d / ws_size %zu\n", n_in, ws_size); grid = -1; return; }
        int dev = 0, cus = 0, per_cu = 0;
        hipGetDevice(&dev);
        hipDeviceGetAttribute(&cus, hipDeviceAttributeMultiprocessorCount, dev);
        hipFuncSetAttribute((const void*)fwd_kernel, hipFuncAttributeMaxDynamicSharedMemorySize, LDS_BYTES);
        if (hipOccupancyMaxActiveBlocksPerMultiprocessor(&per_cu, (const void*)fwd_kernel, NT, LDS_BYTES) != hipSuccess || per_cu < 1) per_cu = 1;
        (void)hipGetLastError();
        grid = cus * per_cu;
        if (grid >= 256) grid = 256;
    }
    if (grid < 0) return;
    if (hipMemsetAsync((char*)d_ws + WS_CTL, 0, 64 * 1024, stream) != hipSuccess) { fprintf(stderr, "memset failed\n"); return; }
    Args a{};
    for (int i = 0; i < 11; ++i) a.in[i] = (const float*)d_in[i];
    a.out = (float*)d_out; a.ws = (unsigned char*)d_ws;
    void* args[] = {&a};
    hipError_t e = hipLaunchCooperativeKernel((const void*)fwd_kernel, dim3(grid), dim3(NT), args, LDS_BYTES, stream);
    if (e != hipSuccess) fprintf(stderr, "cooperative launch failed: %s (grid %d)\n", hipGetErrorString(e), grid);
}
```

```cpp
#include <hip/hip_runtime.h>
#include <hip/hip_cooperative_groups.h>
#include <cstdio>
#include <cstdint>
namespace cg = cooperative_groups;

namespace pg8 {
#define PG8_LAS __attribute__((address_space(3)))
typedef unsigned short bf16_t;
typedef short bf16x8 __attribute__((ext_vector_type(8)));
typedef float f32x4 __attribute__((ext_vector_type(4)));
typedef unsigned u32x4 __attribute__((ext_vector_type(4)));
constexpr int BM = 256, BK = 64, HALF = 128, HTB = HALF * BK * 2, STAGE_BYTES = 8 * HTB, NXCD = 8, WGM = 8;

__host__ __device__ __forceinline__ int lds_byte(int r, int c) { const int st = (r >> 4) * 2 + (c >> 5), rr = r & 15, cc = c & 31, ob = rr * 64 + cc * 2; return st * 1024 + (ob ^ (((ob >> 9) & 1) << 5)); }
__host__ __device__ __forceinline__ void stage_rc(int b, int& R, int& C) { const int st = b / 1024, sb = b % 1024, swz = sb ^ (((sb >> 9) & 1) << 5); R = (st >> 1) * 16 + swz / 64; C = (st & 1) * 32 + (swz % 64) / 2; }
__host__ __device__ __forceinline__ int perm32(int rho) { const int n = rho >> 4, i = rho & 15; return 8 * (i >> 2) + 4 * n + (i & 3); }

struct Unit { int pm, pn; };
struct Gemm { const bf16_t* A; const bf16_t* Bt; int M, N, K; };

struct StaticOrder {
    int nM, nN, nwg, G, c;
    __host__ __device__ void init(int M, int N, int G_, int c_) { nM = M / BM; nN = N / BM; nwg = nM * nN; G = G_; c = c_; }
    __host__ __device__ bool next(int i, Unit& u) const { return at(i, u); }
    __host__ __device__ bool at(int i, Unit& u) const {
        const long L = (long)i * G + c; if (L >= nwg) return false;
        int wgid = (int)L; { const int q = nwg / NXCD, r = nwg % NXCD, xcd = wgid % NXCD, off = wgid / NXCD; wgid = (xcd < r ? xcd * (q + 1) : r * (q + 1) + (xcd - r) * q) + off; }
        const int nig = WGM * nN, gid = wgid / nig, fm = gid * WGM, gsz = (nM - fm) < WGM ? (nM - fm) : WGM;
        u.pm = fm + ((wgid % nig) % gsz); u.pn = (wgid % nig) / gsz; return true;
    }
    __device__ __forceinline__ void a_ready(const Unit&) const {}
    __device__ __forceinline__ void done(const Unit&) const {}
};

struct RoundOrder {
    StaticOrder so; int round;
    __device__ __forceinline__ bool next(int i, Unit& u) const { if (i > 0) return false; return so.at(round, u); }
    __device__ __forceinline__ void a_ready(const Unit&) const {}
    __device__ __forceinline__ void done(const Unit&) const {}
};
__device__ __forceinline__ unsigned cvt_pk_bf16(float lo, float hi) { unsigned r; asm volatile("v_cvt_pk_bf16_f32 %0, %1, %2" : "=v"(r) : "v"(lo), "v"(hi)); return r; }

struct EpiBf16 {
    static constexpr bool PERM = true, AFTER_DRAIN = false;
    bf16_t* O; int ldc; int split_cols; size_t split_stride; int hm; bf16_t* O2; int cmul;
    __device__ __forceinline__ void operator()(const f32x4 (&acc)[2][2][4][2], const Unit& u, int wr, int wc, int fr, int fq) const {
        if (cmul && u.pn >= 4) {
            const int row0 = u.pm * BM + wr * 64 + fr, col0 = (u.pn - 4) * HALF + wc * 32 + 8 * fq;
#pragma unroll
            for (int ai = 0; ai < 2; ++ai)
#pragma unroll
                for (int m = 0; m < 4; ++m) { const f32x4 v0 = acc[ai][0][m][0] * acc[ai][1][m][0], v1 = acc[ai][0][m][1] * acc[ai][1][m][1];
                    u32x4 w; w.x = cvt_pk_bf16(v0[0], v0[1]); w.y = cvt_pk_bf16(v0[2], v0[3]); w.z = cvt_pk_bf16(v1[0], v1[1]); w.w = cvt_pk_bf16(v1[2], v1[3]);
                    *(u32x4*)(O2 + (size_t)(row0 + ai * HALF + m * 16) * 1024 + col0) = w; }
            return;
        }
        const int row0 = u.pm * BM + wr * 64 + fr; int colt = u.pn * BM; bf16_t* base = O; int t = 0;
        if (split_cols) { t = colt / split_cols; base += (size_t)t * split_stride; colt -= t * split_cols; }
        const int col0 = colt + wc * 32 + 8 * fq;
        const bool headmajor = hm && t < 2;
#pragma unroll
        for (int ai = 0; ai < 2; ++ai)
#pragma unroll
            for (int m = 0; m < 4; ++m) { const int row = row0 + ai * HALF + m * 16;
                bf16_t* rowp = headmajor ? base + ((size_t)((row >> 13) * 16 + (col0 >> 6)) * 8192 + (row & 8191)) * 64 + (col0 & 63) : base + (size_t)row * ldc + col0;
                const size_t bjstep = headmajor ? (size_t)2 * 8192 * 64 : (size_t)HALF;
#pragma unroll
                for (int bj = 0; bj < 2; ++bj) { const f32x4 v0 = acc[ai][bj][m][0], v1 = acc[ai][bj][m][1];
                    u32x4 w; w.x = cvt_pk_bf16(v0[0], v0[1]); w.y = cvt_pk_bf16(v0[2], v0[3]); w.z = cvt_pk_bf16(v1[0], v1[1]); w.w = cvt_pk_bf16(v1[2], v1[3]);
                    *(u32x4*)(rowp + bj * bjstep) = w; } }
    }
};
__device__ __forceinline__ float silu_mul(float g, float u) { return g * u * __builtin_amdgcn_rcpf(1.0f + __expf(-g)); }
struct EpiSwiGLU {
    static constexpr bool PERM = true, AFTER_DRAIN = false;
    bf16_t* O; int ldc;
    __device__ __forceinline__ void operator()(const f32x4 (&acc)[2][2][4][2], const Unit& u, int wr, int wc, int fr, int fq) const {
        const int row0 = u.pm * BM + wr * 64 + fr; const int col0 = u.pn * HALF + wc * 32 + 8 * fq;
#pragma unroll
        for (int ai = 0; ai < 2; ++ai)
#pragma unroll
            for (int m = 0; m < 4; ++m) { bf16_t* rowp = O + (size_t)(row0 + ai * HALF + m * 16) * ldc + col0;
                const f32x4 g0 = acc[ai][0][m][0], g1 = acc[ai][0][m][1], u0 = acc[ai][1][m][0], u1 = acc[ai][1][m][1];
                typedef float f32x2 __attribute__((ext_vector_type(2)));
                u32x4 w;
#define PG8_SILU2(G, U, A, B) ([&]() { const f32x2 gg = (f32x2){G[A], G[B]}, uu = (f32x2){U[A], U[B]}; const f32x2 t = gg * (-1.4426950408889634f); \
                    f32x2 e; e.x = __builtin_amdgcn_exp2f(t.x); e.y = __builtin_amdgcn_exp2f(t.y); const f32x2 d = e + 1.0f; f32x2 r; r.x = __builtin_amdgcn_rcpf(d.x); r.y = __builtin_amdgcn_rcpf(d.y); \
                    const f32x2 o = (gg * uu) * r; return cvt_pk_bf16(o.x, o.y); }())
                w.x = PG8_SILU2(g0, u0, 0, 1); w.y = PG8_SILU2(g0, u0, 2, 3); w.z = PG8_SILU2(g1, u1, 0, 1); w.w = PG8_SILU2(g1, u1, 2, 3);
#undef PG8_SILU2
                *(u32x4*)rowp = w; }
    }
};

struct RmsXchg {
    unsigned long long* xbuf;
    unsigned tag;
    __device__ __forceinline__ void run(const f32x4 (&v)[2][2][4][2], const Unit& u, int wr, int wc, int fr, int fq, PG8_LAS unsigned char* lds, int wid, int lane) const {
        PG8_LAS float* P = (PG8_LAS float*)lds;
        PG8_LAS float* S = (PG8_LAS float*)(lds + 4096);
#pragma unroll
        for (int ai = 0; ai < 2; ++ai)
#pragma unroll
            for (int m = 0; m < 4; ++m) {
                float q = 0.f;
#pragma unroll
                for (int bj = 0; bj < 2; ++bj)
#pragma unroll
                    for (int n = 0; n < 2; ++n) { const f32x4 x = v[ai][bj][m][n]; q += (x[0] * x[0] + x[1] * x[1]) + (x[2] * x[2] + x[3] * x[3]); }
                q += __shfl_xor(q, 16); q += __shfl_xor(q, 32);
                if (fq == 0) P[(ai * HALF + wr * 64 + m * 16 + fr) * 4 + wc] = q;
            }
        asm volatile("s_waitcnt lgkmcnt(0)" ::: "memory"); __builtin_amdgcn_s_barrier(); asm volatile("" ::: "memory");
        const int row = wid * 32 + (lane & 31);
        unsigned long long* slot = xbuf + (size_t)(u.pm * BM + row) * 4;
        if (lane < 32) { const f32x4 p = *(const PG8_LAS f32x4*)(P + row * 4); const float t = (p[0] + p[1]) + (p[2] + p[3]);
            __hip_atomic_store(slot + u.pn, ((unsigned long long)tag << 32) | (unsigned long long)__builtin_bit_cast(unsigned, t), __ATOMIC_RELAXED, __HIP_MEMORY_SCOPE_AGENT); }
        float tot = 0.f; unsigned sp = 0u;
        for (;;) {
            bool ok = true; tot = 0.f;
            if (lane < 32) {
#pragma unroll
                for (int k = 0; k < 4; ++k) { const unsigned long long wv = __hip_atomic_load(slot + k, __ATOMIC_RELAXED, __HIP_MEMORY_SCOPE_AGENT); ok = ok && ((unsigned)(wv >> 32) == tag); tot += __builtin_bit_cast(float, (unsigned)wv); }
            }
            if (__builtin_amdgcn_ballot_w64(!ok) == 0ull) break;
            if (++sp > (1u << 22)) break;
            __builtin_amdgcn_s_sleep(1);
        }
        if (lane < 32) S[row] = 1.0f / sqrtf(tot * (1.0f / 1024.0f) + 1e-6f);
        asm volatile("s_waitcnt lgkmcnt(0)" ::: "memory"); __builtin_amdgcn_s_barrier(); asm volatile("" ::: "memory");
    }
};
struct EpiRmsResRms {
    static constexpr bool PERM = true, AFTER_DRAIN = true;
    const float* base; float* out; bf16_t* xn; const float* gain; const float* inv_in; float* inv_out; RmsXchg st1, st2; int write_xn, write_out;
    __device__ __forceinline__ void fused(f32x4 (&acc)[2][2][4][2], const Unit& u, int wr, int wc, int fr, int fq, PG8_LAS unsigned char* lds, int wid, int lane) const {
        const PG8_LAS float* S = (const PG8_LAS float*)(lds + 4096);
        const int col0 = u.pn * BM + wc * 32 + 8 * fq;
        u32x4 pre[4][2]; float ivs[4], ivs1[4];
        if (!base) {
#pragma unroll
            for (int m = 0; m < 4; ++m) { const int r = wr * 64 + m * 16 + fr; const size_t off = (size_t)(u.pm * BM + r) * 1024 + col0; ivs[m] = inv_in[u.pm * BM + r]; ivs1[m] = inv_in[u.pm * BM + HALF + r];
#pragma unroll
                for (int bj = 0; bj < 2; ++bj) pre[m][bj] = *(const u32x4*)(xn + off + bj * HALF); }
        }
        f32x4 gq[2][2];
#pragma unroll
        for (int bj = 0; bj < 2; ++bj) { gq[bj][0] = *(const f32x4*)(gain + col0 + bj * HALF); gq[bj][1] = *(const f32x4*)(gain + col0 + bj * HALF + 4); }
        st1.run(acc, u, wr, wc, fr, fq, lds, wid, lane);
#pragma unroll
        for (int ai = 0; ai < 2; ++ai)
#pragma unroll
            for (int m = 0; m < 4; ++m) { const int r = ai * HALF + wr * 64 + m * 16 + fr; const float rs = S[r]; const size_t off = (size_t)(u.pm * BM + r) * 1024 + col0;
#pragma unroll
                for (int bj = 0; bj < 2; ++bj) { f32x4 b0, b1;
                    if (base) { b0 = *(const f32x4*)(base + off + bj * HALF); b1 = *(const f32x4*)(base + off + bj * HALF + 4); }
                    else { const u32x4 w = (ai == 0) ? pre[m][bj] : *(const u32x4*)(xn + off + bj * HALF); const float iv = (ai == 0) ? ivs[m] : ivs1[m];
                        b0 = (f32x4){__builtin_bit_cast(float, w.x << 16), __builtin_bit_cast(float, w.x & 0xffff0000u), __builtin_bit_cast(float, w.y << 16), __builtin_bit_cast(float, w.y & 0xffff0000u)} * iv;
                        b1 = (f32x4){__builtin_bit_cast(float, w.z << 16), __builtin_bit_cast(float, w.z & 0xffff0000u), __builtin_bit_cast(float, w.w << 16), __builtin_bit_cast(float, w.w & 0xffff0000u)} * iv; }
                    acc[ai][bj][m][0] = b0 + acc[ai][bj][m][0] * rs * gq[bj][0]; acc[ai][bj][m][1] = b1 + acc[ai][bj][m][1] * rs * gq[bj][1]; }
                asm volatile("" : "+v"(acc[ai][0][m][0]), "+v"(acc[ai][0][m][1]), "+v"(acc[ai][1][m][0]), "+v"(acc[ai][1][m][1])); }
        if (write_xn) st2.run(acc, u, wr, wc, fr, fq, lds, wid, lane);
#pragma unroll
        for (int ai = 0; ai < 2; ++ai)
#pragma unroll
            for (int m = 0; m < 4; ++m) { const int r = ai * HALF + wr * 64 + m * 16 + fr; const float rs = S[r]; const size_t off = (size_t)(u.pm * BM + r) * 1024 + col0;
#pragma unroll
                for (int bj = 0; bj < 2; ++bj) { const f32x4 x0 = acc[ai][bj][m][0], x1 = acc[ai][bj][m][1];
                    if (write_out) { *(f32x4*)(out + off + bj * HALF) = x0; *(f32x4*)(out + off + bj * HALF + 4) = x1; }
                    if (write_xn) { const f32x4 o0 = x0 * rs, o1 = x1 * rs; u32x4 w; w.x = cvt_pk_bf16(o0[0], o0[1]); w.y = cvt_pk_bf16(o0[2], o0[3]); w.z = cvt_pk_bf16(o1[0], o1[1]); w.w = cvt_pk_bf16(o1[2], o1[3]);
                        *(u32x4*)(xn + off + bj * HALF) = w; } }
                asm volatile("" ::: "memory"); }
        if (write_xn && u.pn == 0 && lane < 32) inv_out[u.pm * BM + wid * 32 + lane] = 1.0f / S[wid * 32 + lane];
    }
};

template <class Epi, class Sched, bool ALIGN_EPI = false, bool SP2 = false>
__device__ __forceinline__ void gemm_phase(PG8_LAS unsigned char* lds, const Gemm g, const Sched& S, const Epi& E) {
    int tid = threadIdx.x; asm volatile("" : "+v"(tid));
    const int wid = __builtin_amdgcn_readfirstlane(tid >> 6), lane = tid & 63, wr = wid >> 2, wc = wid & 3, fr = lane & 15, fq = lane >> 4;
    const int K = g.K, nt = K / BK;
    unsigned voffA[2], voffB[2];
#pragma unroll
    for (int i = 0; i < 2; ++i) { int R, C; stage_rc(tid * 16 + i * 8192, R, C); const int Rb = Epi::PERM ? ((R & ~31) + perm32(R & 31)) : R;
        voffA[i] = (unsigned)(R * K + C) * 2u; voffB[i] = (unsigned)(Rb * K + C) * 2u; }
    const size_t kstep = (size_t)(BK * 2);
    const size_t hstep = (size_t)HALF * K * 2;
    const size_t tstep = 2 * hstep;
    const unsigned ldsw = (unsigned)wid * 1024u;
    const int aoff = lds_byte(wr * 64 + fr, fq * 8), boff = lds_byte(wc * 32 + fr, fq * 8);
#define PG8_SA(b, h) (((b) * 2 + (h)) * HTB)
#define PG8_SB(b, h) ((4 + (b) * 2 + (h)) * HTB)
#define PG8_STAGE(bufoff, gbase, voff) do { _Pragma("unroll") for (int _i = 0; _i < 2; ++_i) \
        __builtin_amdgcn_global_load_lds((const unsigned*)((const char*)(gbase) + (voff)[_i]), (PG8_LAS unsigned*)(lds + (bufoff) + ldsw + _i * 8192), 16, 0, 0); } while (0)
#define PG8_LDA(dst, b, h) do { _Pragma("unroll") for (int m = 0; m < 4; ++m) _Pragma("unroll") for (int k = 0; k < 2; ++k) dst[m][k] = *(const PG8_LAS bf16x8*)(lds + PG8_SA(b, h) + aoff + m * 2048 + k * 1024); } while (0)
#define PG8_LDB(dst, b, h) do { _Pragma("unroll") for (int n = 0; n < 2; ++n) _Pragma("unroll") for (int k = 0; k < 2; ++k) dst[n][k] = *(const PG8_LAS bf16x8*)(lds + PG8_SB(b, h) + boff + n * 2048 + k * 1024); } while (0)
#define PG8_MMA(ai, bj, At, Bt) do { __builtin_amdgcn_s_setprio(1); _Pragma("unroll") for (int m = 0; m < 4; ++m) _Pragma("unroll") for (int n = 0; n < 2; ++n) _Pragma("unroll") for (int k = 0; k < 2; ++k) \
        acc[ai][bj][m][n] = __builtin_amdgcn_mfma_f32_16x16x32_bf16(Bt[n][k], At[m][k], acc[ai][bj][m][n], 0, 0, 0); __builtin_amdgcn_s_setprio(0); } while (0)
#define PG8_WAIT_V(n) asm volatile("s_waitcnt vmcnt(" #n ")" ::: "memory")
#define PG8_WAIT_L(n) asm volatile("s_waitcnt lgkmcnt(" #n ")" ::: "memory")
#define PG8_BAR __builtin_amdgcn_s_barrier()
#define PG8_SCHED __builtin_amdgcn_sched_barrier(0)
    Unit cur, nxt; int ui = 0;
    if (!S.next(0, cur)) return;
    f32x4 acc[2][2][4][2];
#pragma unroll
    for (int a = 0; a < 2; ++a)
#pragma unroll
        for (int b = 0; b < 2; ++b)
#pragma unroll
            for (int m = 0; m < 4; ++m)
#pragma unroll
                for (int n = 0; n < 2; ++n) acc[a][b][m][n] = (f32x4){0.f, 0.f, 0.f, 0.f};
    bf16x8 At[4][2], B0[2][2], B1[2][2];
    const char* cA = (const char*)g.A + (size_t)cur.pm * tstep; const char* cB = (const char*)g.Bt + (size_t)cur.pn * tstep;
    S.a_ready(cur);
    if constexpr (SP2) {
        PG8_STAGE(PG8_SB(0, 0), cB, voffB); PG8_STAGE(PG8_SB(0, 1), cB + hstep, voffB); PG8_STAGE(PG8_SA(0, 0), cA, voffA); PG8_STAGE(PG8_SA(0, 1), cA + hstep, voffA);
        if (wr == 1) PG8_BAR;
        PG8_WAIT_V(2); PG8_BAR;
        PG8_STAGE(PG8_SB(1, 0), cB + kstep, voffB); PG8_STAGE(PG8_SA(1, 0), cA + kstep, voffA); PG8_STAGE(PG8_SB(1, 1), cB + hstep + kstep, voffB);
        PG8_WAIT_V(6); PG8_BAR;
    } else {
        PG8_STAGE(PG8_SB(0, 0), cB, voffB); PG8_STAGE(PG8_SA(0, 0), cA, voffA); PG8_STAGE(PG8_SB(0, 1), cB + hstep, voffB); PG8_STAGE(PG8_SA(0, 1), cA + hstep, voffA);
        if (wr == 1) PG8_BAR;
        PG8_WAIT_V(4); PG8_BAR;
        PG8_STAGE(PG8_SB(1, 0), cB + kstep, voffB); PG8_STAGE(PG8_SA(1, 0), cA + kstep, voffA); PG8_STAGE(PG8_SB(1, 1), cB + hstep + kstep, voffB);
        PG8_WAIT_V(6); PG8_BAR;
    }
    for (;;) {
        const bool has_next = S.next(ui + 1, nxt);
        const char* nA = has_next ? (const char*)g.A + (size_t)nxt.pm * tstep : cA; const char* nB = has_next ? (const char*)g.Bt + (size_t)nxt.pn * tstep : cB;
        for (int t = 0; t < nt; t += 2) {
            const bool last = (t == nt - 2);
            const char* a1 = cA + (size_t)(t + 1) * kstep;
            const char* a2 = last ? nA : cA + (size_t)(t + 2) * kstep; const char* b2 = last ? nB : cB + (size_t)(t + 2) * kstep;
            const char* a3 = a2 + kstep; const char* b3 = b2 + kstep;
            if (last && has_next) S.a_ready(nxt);
            if constexpr (SP2) {
            PG8_LDB(B0, 0, 0); PG8_LDB(B1, 0, 1); PG8_SCHED; PG8_LDA(At, 0, 0); PG8_STAGE(PG8_SA(1, 1), a1 + hstep, voffA);
            PG8_WAIT_V(8); PG8_WAIT_L(0); PG8_BAR; PG8_MMA(0, 0, At, B0); PG8_MMA(0, 1, At, B1); PG8_BAR; PG8_SCHED;
            PG8_LDA(At, 0, 1); PG8_STAGE(PG8_SB(0, 0), b2, voffB); PG8_STAGE(PG8_SB(0, 1), b2 + hstep, voffB); PG8_STAGE(PG8_SA(0, 0), a2, voffA);
            PG8_WAIT_V(8); PG8_WAIT_L(0); PG8_BAR; PG8_MMA(1, 0, At, B0); PG8_MMA(1, 1, At, B1); PG8_BAR; PG8_SCHED;
            PG8_LDB(B0, 1, 0); PG8_LDB(B1, 1, 1); PG8_SCHED; PG8_LDA(At, 1, 0); PG8_STAGE(PG8_SA(0, 1), a2 + hstep, voffA);
            PG8_WAIT_V(8); PG8_WAIT_L(0); PG8_BAR; PG8_MMA(0, 0, At, B0); PG8_MMA(0, 1, At, B1); PG8_BAR; PG8_SCHED;
            PG8_LDA(At, 1, 1); PG8_STAGE(PG8_SB(1, 0), b3, voffB); PG8_STAGE(PG8_SB(1, 1), b3 + hstep, voffB); PG8_STAGE(PG8_SA(1, 0), a3, voffA);
            PG8_WAIT_V(8); PG8_WAIT_L(0); PG8_BAR; PG8_MMA(1, 0, At, B0); PG8_MMA(1, 1, At, B1); PG8_BAR; PG8_SCHED;
            } else {
            PG8_LDB(B0, 0, 0); PG8_SCHED; PG8_LDA(At, 0, 0); PG8_STAGE(PG8_SA(1, 1), a1 + hstep, voffA);
            PG8_WAIT_L(8); PG8_BAR; PG8_WAIT_L(0); PG8_MMA(0, 0, At, B0); PG8_BAR; PG8_SCHED;
            PG8_LDB(B1, 0, 1); PG8_STAGE(PG8_SB(0, 0), b2, voffB);
            PG8_BAR; PG8_WAIT_L(0); PG8_MMA(0, 1, At, B1); PG8_BAR;
            PG8_LDA(At, 0, 1); PG8_STAGE(PG8_SA(0, 0), a2, voffA);
            PG8_BAR; PG8_WAIT_L(0); PG8_MMA(1, 0, At, B0); PG8_BAR; PG8_SCHED;
            PG8_STAGE(PG8_SB(0, 1), b2 + hstep, voffB);
            PG8_WAIT_V(6); PG8_BAR; PG8_MMA(1, 1, At, B1); PG8_BAR;
            PG8_LDB(B0, 1, 0); PG8_SCHED; PG8_LDA(At, 1, 0); PG8_STAGE(PG8_SA(0, 1), a2 + hstep, voffA);
            PG8_WAIT_L(8); PG8_BAR; PG8_WAIT_L(0); PG8_MMA(0, 0, At, B0); PG8_BAR; PG8_SCHED;
            PG8_LDB(B1, 1, 1); PG8_STAGE(PG8_SB(1, 0), b3, voffB);
            PG8_BAR; PG8_WAIT_L(0); PG8_MMA(0, 1, At, B1); PG8_BAR;
            PG8_LDA(At, 1, 1); PG8_STAGE(PG8_SA(1, 0), a3, voffA);
            PG8_BAR; PG8_WAIT_L(0); PG8_MMA(1, 0, At, B0); PG8_BAR; PG8_SCHED;
            PG8_STAGE(PG8_SB(1, 1), b3 + hstep, voffB);
            PG8_WAIT_V(6); PG8_BAR; PG8_MMA(1, 1, At, B1); PG8_BAR;
            }
        }
        if constexpr (ALIGN_EPI) { if (wr == 0) PG8_BAR; }
        if constexpr (!Epi::AFTER_DRAIN) { E(acc, cur, wr, wc, fr, fq); S.done(cur); }
        if (!has_next) break;
#pragma unroll
        for (int a = 0; a < 2; ++a)
#pragma unroll
            for (int b = 0; b < 2; ++b)
#pragma unroll
                for (int m = 0; m < 4; ++m)
#pragma unroll
                    for (int n = 0; n < 2; ++n) acc[a][b][m][n] = (f32x4){0.f, 0.f, 0.f, 0.f};
        cur = nxt; cA = nA; cB = nB; ++ui;
        if constexpr (ALIGN_EPI) { if (wr == 1) PG8_BAR; }
    }
    PG8_WAIT_V(0);
    if constexpr (!ALIGN_EPI) { if (wr == 0) PG8_BAR; }
    PG8_BAR;
    if constexpr (Epi::AFTER_DRAIN) { E.fused(acc, cur, wr, wc, fr, fq, lds, wid, lane); S.done(cur); }
#undef PG8_SA
#undef PG8_SB
#undef PG8_STAGE
#undef PG8_LDA
#undef PG8_LDB
#undef PG8_MMA
#undef PG8_WAIT_V
#undef PG8_WAIT_L
#undef PG8_BAR
#undef PG8_SCHED
}
}

#define LAS __attribute__((address_space(3)))
typedef unsigned short bf16;
typedef unsigned v4u __attribute__((ext_vector_type(4)));
typedef unsigned v2u __attribute__((ext_vector_type(2)));
typedef float f32x4 __attribute__((ext_vector_type(4)));
constexpr int NWAVES = 8, NT = 512;
constexpr int BATCH = 4, SEQ = 8192, D = 1024, M = BATCH * SEQ, NH = 16, HD = 64, FF = 2816, DEPTH = 4;
constexpr float EPS = 1e-6f;
constexpr size_t MiB = 1u << 20;
constexpr size_t WS_CTL = 0, WS_LSE = 1 * MiB, WS_W0 = 4 * MiB, WS_W1 = 29 * MiB, WS_XN = 54 * MiB, WS_G = 118 * MiB, WS_KV = 182 * MiB, WS_H = 310 * MiB, WS_XB = 486 * MiB, WS_INV = 490 * MiB, WS_END = 491 * MiB;
constexpr int CW_SEAM = 16384, SEAM_BANK = 128 * 64;
constexpr size_t WO_1 = 0, WO_3 = 6 * MiB, WO_FI = 8 * MiB, WO_FO = 19 * MiB;
constexpr int LDS_BYTES = 131072 + 1024;

struct Args { const float* in[11]; float* out; unsigned char* ws; };

__device__ __forceinline__ unsigned f2bf(float f) { unsigned u = __builtin_bit_cast(unsigned, f); return (u + 0x7fffu + ((u >> 16) & 1u)) >> 16; }
__device__ __forceinline__ unsigned pk2(float lo, float hi) { return f2bf(lo) | (f2bf(hi) << 16); }
__device__ __forceinline__ float bflo(unsigned w) { return __builtin_bit_cast(float, w << 16); }
__device__ __forceinline__ float bfhi(unsigned w) { return __builtin_bit_cast(float, w & 0xffff0000u); }
__device__ __forceinline__ float wave_sum(float v) {
#pragma unroll
    for (int o = 1; o < 64; o <<= 1) v += __shfl_xor(v, o);
    return v;
}
__device__ __forceinline__ float wave_max(float v) {
#pragma unroll
    for (int o = 1; o < 64; o <<= 1) v = fmaxf(v, __shfl_xor(v, o));
    return v;
}
#define LDS_WAIT() asm volatile("s_waitcnt lgkmcnt(0)" ::: "memory")
template <class T> __device__ __forceinline__ T* opq(T* p) { size_t z = 0; asm volatile("" : "+s"(z)); return (T*)((unsigned char*)p + z); }
__device__ __forceinline__ int opqv(int v) { asm volatile("" : "+v"(v)); return v; }

__device__ __forceinline__ void tr_item(const float* W, int K, int N, const float* gain, float scale, bf16* WT, int swiglu, int row_off, LAS float* scr, int item, int lane) {
    const int nblk = N / 32, kb = item / nblk, nb = item % nblk, k0 = 64 * kb, n0 = 32 * nb;
    {
        const int kq = lane >> 3, n4 = (lane & 7) * 4;
        f32x4 wv[8];
#pragma unroll
        for (int i = 0; i < 8; ++i) wv[i] = *(const f32x4*)(W + (size_t)(k0 + 8 * i + kq) * N + n0 + n4);
#pragma unroll
        for (int i = 0; i < 8; ++i) { const int kk = 8 * i + kq; const float gk = gain ? gain[k0 + kk] * scale : scale;
            scr[kk * 33 + n4 + 0] = wv[i][0] * gk; scr[kk * 33 + n4 + 1] = wv[i][1] * gk; scr[kk * 33 + n4 + 2] = wv[i][2] * gk; scr[kk * 33 + n4 + 3] = wv[i][3] * gk; }
    }
    LDS_WAIT(); asm volatile("" ::: "memory");
    int drow0 = n0;
    if (swiglu == 1) drow0 = (n0 < FF) ? ((n0 >> 7) * 256 + (n0 & 127)) : (((n0 - FF) >> 7) * 256 + 128 + ((n0 - FF) & 127));
    if (swiglu == 2) drow0 = (n0 < D) ? n0 : ((n0 < 2 * D) ? (D + ((n0 - D) >> 7) * 256 + ((n0 - D) & 127)) : (D + ((n0 - 2 * D) >> 7) * 256 + 128 + ((n0 - 2 * D) & 127)));
    drow0 += row_off;
    const int c = lane & 7;
#pragma unroll
    for (int j = 0; j < 4; ++j) { const int n = (lane >> 3) + 8 * j; const LAS float* s = scr + (8 * c) * 33 + n;
        v4u o; o.x = pk2(s[0 * 33], s[1 * 33]); o.y = pk2(s[2 * 33], s[3 * 33]); o.z = pk2(s[4 * 33], s[5 * 33]); o.w = pk2(s[6 * 33], s[7 * 33]);
        *(v4u*)(WT + (size_t)(drow0 + n) * K + k0 + 8 * c) = o; }
    LDS_WAIT(); asm volatile("" ::: "memory");
}
__device__ __forceinline__ void convert_layer(const Args& a, int l, unsigned char* wbuf, LAS float* scr, int gw, int NGW, int lane) {
    const float* ng = a.in[1] + (size_t)l * 4 * D;
    bf16* W1 = (bf16*)(wbuf + WO_1); bf16* W3 = (bf16*)(wbuf + WO_3); bf16* WFI = (bf16*)(wbuf + WO_FI); bf16* WFO = (bf16*)(wbuf + WO_FO);
    const int n0 = (l < 2) ? 1536 : (l == 2 ? 1024 : 0), n1 = (l < 2) ? 0 : 512, n2 = 512, n3 = 2816, n4 = 1408;
    const int total = n0 + n1 + n2 + n3 + n4;
    for (int it = gw; it < total; it += NGW) {
        int r = it;
        if (r < n0) { if (l < 2) tr_item(a.in[2] + (size_t)l * D * 3 * D, D, 3 * D, ng, 1.f, W1, 2, 0, scr, r, lane);
                      else tr_item(a.in[6], D, 2 * D, a.in[5], 1.f, W1, 0, 0, scr, r, lane); continue; } r -= n0;
        if (r < n1) { tr_item(a.in[7] + (size_t)(l - 2) * D * D, D, D, ng, 0.125f * 1.4426950408889634f, W1, 0, (l == 2) ? 2 * D : 0, scr, r, lane); continue; } r -= n1;
        if (r < n2) { tr_item((l < 2) ? a.in[4] + (size_t)l * D * D : a.in[8] + (size_t)(l - 2) * D * D, D, D, nullptr, 1.f, W3, 0, 0, scr, r, lane); continue; } r -= n2;
        if (r < n3) { tr_item(a.in[9] + (size_t)l * D * 2 * FF, D, 2 * FF, ng + 2 * D, 1.f, WFI, 1, 0, scr, r, lane); continue; } r -= n3;
        tr_item(a.in[10] + (size_t)l * FF * D, FF, D, nullptr, 1.f, WFO, 0, 0, scr, r, lane);
    }
}
__device__ __forceinline__ void unpack8(const v4u w, float (&f)[8]) { f[0] = bflo(w.x); f[1] = bfhi(w.x); f[2] = bflo(w.y); f[3] = bfhi(w.y); f[4] = bflo(w.z); f[5] = bfhi(w.z); f[6] = bflo(w.w); f[7] = bfhi(w.w); }
__device__ __forceinline__ void conv_phase(const bf16* Bg, const bf16* U, const float* wconv, bf16* Aout, int bid, int G, int tid) {
    const int cgp = tid & 127, rc = tid >> 7, c0 = cgp * 8;
    float w0[8], w1[8], w2[8];
#pragma unroll
    for (int e = 0; e < 8; ++e) { w0[e] = wconv[c0 + e]; w1[e] = wconv[D + c0 + e]; w2[e] = wconv[2 * D + c0 + e]; }
    for (int it = bid; it < M / 128; it += G) {
        const int row0 = it * 128 + rc * 32;
        float um2[8], um1[8];
        if ((row0 & (SEQ - 1)) == 0) {
#pragma unroll
            for (int e = 0; e < 8; ++e) { um2[e] = 0.f; um1[e] = 0.f; }
        } else { unpack8(*(const v4u*)(U + (size_t)(row0 - 2) * D + c0), um2); unpack8(*(const v4u*)(U + (size_t)(row0 - 1) * D + c0), um1); }
#pragma unroll 4
        for (int r = 0; r < 32; ++r) {
            float b[8], u[8], o[8];
            unpack8(*(const v4u*)(Bg + (size_t)(row0 + r) * D + c0), b); unpack8(*(const v4u*)(U + (size_t)(row0 + r) * D + c0), u);
#pragma unroll
            for (int e = 0; e < 8; ++e) { o[e] = b[e] * (w0[e] * um2[e] + w1[e] * um1[e] + w2[e] * u[e]); um2[e] = um1[e]; um1[e] = u[e]; }
            v4u w; w.x = pk2(o[0], o[1]); w.y = pk2(o[2], o[3]); w.z = pk2(o[4], o[5]); w.w = pk2(o[6], o[7]);
            *(v4u*)(Aout + (size_t)(row0 + r) * D + c0) = w;
        }
    }
}
typedef short bf16x8 __attribute__((ext_vector_type(8)));
typedef short s16x4 __attribute__((ext_vector_type(4)));
constexpr int KSTR = 144, VSTR = 160, LDS_KOFF = 0, LDS_VOFF = 256 * KSTR, LDS_OSC = 81920;
__device__ __forceinline__ s16x4 vtr(const LAS unsigned char* p) { return __builtin_amdgcn_ds_read_tr16_b64_v4i16((LAS s16x4*)p); }
struct AttBlk { int dl, r, n, g; };
__device__ __forceinline__ AttBlk att_decode(int bi, int sp) { AttBlk k; k.g = bi >> 4; const int j = bi & 15; k.dl = 1 << (2 * k.g);
    k.r = (k.g == 0) ? 0 : (k.g == 1 ? (j >> 2) : j); k.n = (k.g == 0) ? 16 * sp + j : (k.g == 1 ? 4 * sp + (j & 3) : sp); return k; }
__device__ __forceinline__ void att_prefetch(const bf16* Q, const bf16* K, const bf16* V, size_t headoff, int b, int h, int sp, int bi, int skk, int spart, int w, int fr, int fq,
                                             v4u (&pk)[4], v4u (&pv)[4], bf16x8& q0, bf16x8& q1, const bf16* O, const float* LSE, v4u (&op)[2], float& lp) {
    const AttBlk k = att_decode(bi, sp);
    const unsigned char* Kb = (const unsigned char*)(K + headoff); const unsigned char* Vb = (const unsigned char*)(V + headoff);
    const int tok0 = ((k.n - 1) * 128) * k.dl + k.r;
#pragma unroll
    for (int i = 0; i < 4; ++i) { const int kk = skk + 64 * i; int tok = tok0 + kk * k.dl; tok = tok < 0 ? 0 : tok;
        const unsigned off = (unsigned)tok * (HD * 2) + (unsigned)spart * 16u; pk[i] = *(const v4u*)(Kb + off); pv[i] = *(const v4u*)(Vb + off); }
    const unsigned char* Qb = (const unsigned char*)(Q + (size_t)b * SEQ * D + h * HD); const unsigned char* Ob = (const unsigned char*)(O + (size_t)b * SEQ * D + h * HD);
    const float* Lb = LSE + (size_t)(b * NH + h) * SEQ;
    const int t0 = (128 * k.n + 16 * w) * k.dl + k.r;
    const unsigned qt = (unsigned)(t0 + fr * k.dl);
    const unsigned qoff = qt * (D * 2) + (unsigned)fq * 16u;
    q0 = *(const bf16x8*)(Qb + qoff); q1 = *(const bf16x8*)(Qb + qoff + 64);
    lp = Lb[qt];
    const int lane_ = fr + 16 * fq;
#pragma unroll
    for (int i = 0; i < 2; ++i) { const unsigned ot = (unsigned)(t0 + ((lane_ >> 3) + 8 * i) * k.dl); op[i] = *(const v4u*)(Ob + ot * (D * 2) + (unsigned)(lane_ & 7) * 16u); }
}
template <int MODE> __device__ __forceinline__ void att_block(const bf16* Q, const bf16* K, const bf16* V, bf16* O, float* LSE, LAS unsigned char* lds, size_t headoff, float slope2, int b, int h, int sp, int bi,
                                          int skk, int spart, int w, int fr, int fq, v4u (&pk)[4], v4u (&pv)[4], bf16x8& qa, bf16x8& qb, v4u (&opn)[2], float& lpn) {
    const AttBlk k = att_decode(bi, sp);
    const int dl = k.dl, r = k.r, n = k.n, g = k.g;
    asm volatile("s_waitcnt vmcnt(12)" ::: "memory");
    __syncthreads();
    const int uq = 16 * w + fr;
    const size_t qrow = (size_t)b * SEQ + (size_t)(128 * n + uq) * dl + r;
    float lse_prev = lpn; unsigned long long oprev[4];
    LAS unsigned char* osc = lds + LDS_OSC + w * 2304;
    const int lane_ = fr + 16 * fq;
#pragma unroll
    for (int i = 0; i < 2; ++i) *(LAS v4u*)(osc + ((lane_ >> 3) + 8 * i) * 144 + (lane_ & 7) * 16) = opn[i];
#pragma unroll
    for (int dt = 0; dt < 4; ++dt) oprev[dt] = *(const LAS unsigned long long*)(osc + fr * 144 + 32 * dt + 8 * fq);
#pragma unroll
    for (int i = 0; i < 4; ++i) { const int kk = skk + 64 * i; const bool z = (n == 0) && (i < 2);
        const v4u kz = z ? (v4u){0u, 0u, 0u, 0u} : pk[i], vz = z ? (v4u){0u, 0u, 0u, 0u} : pv[i];
        *(LAS v4u*)(lds + LDS_KOFF + kk * KSTR + spart * 16) = kz; *(LAS v4u*)(lds + LDS_VOFF + kk * VSTR + spart * 16) = vz; }
    const bf16x8 q0 = qa, q1 = qb;
    __syncthreads();
    att_prefetch(Q, K, V, headoff, b, h, sp, (bi + 2 < 48) ? bi + 2 : 47, skk, spart, w, fr, fq, pk, pv, qa, qb, O, LSE, opn, lpn);
    float l_run = 0.f; f32x4 oacc[4]; float m_run = 0.f;
#pragma unroll
    for (int dt = 0; dt < 4; ++dt) oacc[dt] = (f32x4){0.f, 0.f, 0.f, 0.f};
    if (MODE & 1) {
    const float bsl = slope2 * (float)dl;
    const float c0 = -bsl * (float)(fr + 128 - 4 * fq); const f32x4 B0 = (f32x4){c0, c0 + bsl, c0 + 2.f * bsl, c0 + 3.f * bsl};
    f32x4 sv[9];
    {
        const LAS unsigned char* kbase = lds + LDS_KOFF + (16 * w + fr) * KSTR + 16 * fq;
        bf16x8 kf[3][2];
#pragma unroll
        for (int bt = 0; bt < 3; ++bt) {
#pragma unroll
            for (int t = 0; t < 3; ++t) { kf[t][0] = *(const LAS bf16x8*)(kbase + (16 * (3 * bt + t)) * KSTR); kf[t][1] = *(const LAS bf16x8*)(kbase + (16 * (3 * bt + t)) * KSTR + 64); }
            __builtin_amdgcn_sched_barrier(0);
#pragma unroll
            for (int t = 0; t < 3; ++t) { f32x4 acc0 = B0;
                acc0 = __builtin_amdgcn_mfma_f32_16x16x32_bf16(kf[t][0], q0, acc0, 0, 0, 0); acc0 = __builtin_amdgcn_mfma_f32_16x16x32_bf16(kf[t][1], q1, acc0, 0, 0, 0);
                sv[3 * bt + t] = acc0; }
            __builtin_amdgcn_sched_barrier(0);
        }
    }
#pragma unroll
    for (int v = 0; v < 4; ++v) { if (4 * fq + v < fr) sv[0][v] = -INFINITY; if (4 * fq + v > fr) sv[8][v] = -INFINITY; }
    float tj[9];
#pragma unroll
    for (int jj = 0; jj < 9; ++jj) tj[jj] = (n == 0 && w + jj < 8) ? -INFINITY : bsl * (float)(16 * jj);
    float mloc = -INFINITY;
#pragma unroll
    for (int jj = 0; jj < 9; ++jj) mloc = fmaxf(mloc, fmaxf(fmaxf(sv[jj][0], sv[jj][1]), fmaxf(sv[jj][2], sv[jj][3])) + tj[jj]);
    mloc = fmaxf(mloc, __shfl_xor(mloc, 16)); mloc = fmaxf(mloc, __shfl_xor(mloc, 32));
    m_run = mloc;
    unsigned pw[10][2];
#pragma unroll
    for (int jj = 0; jj < 9; ++jj) { float pe[4]; const float dj = tj[jj] - mloc;
#pragma unroll
        for (int v = 0; v < 4; ++v) { pe[v] = __builtin_amdgcn_exp2f(sv[jj][v] + dj); l_run += pe[v]; }
        pw[jj][0] = pg8::cvt_pk_bf16(pe[0], pe[1]); pw[jj][1] = pg8::cvt_pk_bf16(pe[2], pe[3]); }
    pw[9][0] = 0u; pw[9][1] = 0u;
    {
        const LAS unsigned char* vbase = lds + LDS_VOFF + (16 * w + 4 * fq + (fr >> 2)) * VSTR + (4 * (fr & 3)) * 2;
        s16x4 vf[4][2], vn[4][2];
#pragma unroll
        for (int dt = 0; dt < 4; ++dt) { vf[dt][0] = vtr(vbase + 32 * dt); vf[dt][1] = vtr(vbase + 32 * dt + 16 * VSTR); }
#pragma unroll
        for (int pp = 0; pp < 5; ++pp) {
            if (pp < 4) {
#pragma unroll
                for (int dt = 0; dt < 4; ++dt) { vn[dt][0] = vtr(vbase + 32 * (pp + 1) * VSTR + 32 * dt); vn[dt][1] = vtr(vbase + 32 * (pp + 1) * VSTR + 32 * dt + 16 * VSTR); }
            }
            __builtin_amdgcn_sched_barrier(0);
            const v4u pq = (v4u){pw[2 * pp][0], pw[2 * pp][1], pw[2 * pp + 1][0], pw[2 * pp + 1][1]};
            const bf16x8 pfrag = __builtin_bit_cast(bf16x8, pq);
#pragma unroll
            for (int dt = 0; dt < 4; ++dt) {
                const bf16x8 af = (bf16x8){vf[dt][0][0], vf[dt][0][1], vf[dt][0][2], vf[dt][0][3], vf[dt][1][0], vf[dt][1][1], vf[dt][1][2], vf[dt][1][3]};
                oacc[dt] = __builtin_amdgcn_mfma_f32_16x16x32_bf16(af, pfrag, oacc[dt], 0, 0, 0);
            }
            __builtin_amdgcn_sched_barrier(0);
            if (pp < 4) {
#pragma unroll
                for (int dt = 0; dt < 4; ++dt) { vf[dt][0] = vn[dt][0]; vf[dt][1] = vn[dt][1]; }
            }
        }
    }
    } else { l_run = 1.f; }
    float l = l_run; l += __shfl_xor(l, 16); l += __shfl_xor(l, 32);
    if (g == 0) { lse_prev = -INFINITY; oprev[0] = 0ull; oprev[1] = 0ull; oprev[2] = 0ull; oprev[3] = 0ull; }
    const float m_tot = fmaxf(lse_prev, m_run), wp = __builtin_amdgcn_exp2f(lse_prev - m_tot), wcur = __builtin_amdgcn_exp2f(m_run - m_tot);
    const float denom = wp + l * wcur, inv = __builtin_amdgcn_rcpf(denom), cp = wp * inv, cc = wcur * inv;
#pragma unroll
    for (int dt = 0; dt < 4; ++dt) { const unsigned lo = (unsigned)oprev[dt], hi = (unsigned)(oprev[dt] >> 32); const f32x4 op = (f32x4){bflo(lo), bfhi(lo), bflo(hi), bfhi(hi)};
        const f32x4 o = op * cp + oacc[dt] * cc; v2u ov; ov.x = pg8::cvt_pk_bf16(o[0], o[1]); ov.y = pg8::cvt_pk_bf16(o[2], o[3]);
        *(LAS v2u*)(osc + fr * 144 + 32 * dt + 8 * fq) = ov; }
#pragma unroll
    for (int i = 0; i < 2; ++i) { const v4u rowv = *(const LAS v4u*)(osc + ((lane_ >> 3) + 8 * i) * 144 + (lane_ & 7) * 16);
        const size_t orow = (size_t)b * SEQ + (size_t)(128 * n + 16 * w + (lane_ >> 3) + 8 * i) * dl + r; *(v4u*)(O + orow * D + h * HD + (lane_ & 7) * 8) = rowv; }
    if (fq == 0) LSE[(size_t)(b * NH + h) * SEQ + (qrow - (size_t)b * SEQ)] = m_tot + __builtin_amdgcn_logf(denom);
}
template <int MODE> __device__ __forceinline__ void attn_fast(const bf16* Q, const bf16* K, const bf16* V, bf16* O, float* LSE, LAS unsigned char* lds, int bid, int G, int tid) {
    const int lane = tid & 63, w = __builtin_amdgcn_readfirstlane(tid >> 6), fr = lane & 15, fq = lane >> 4;
    for (int i = tid; i < 16 * VSTR / 4; i += NT) ((LAS unsigned*)(lds + LDS_VOFF + 256 * VSTR))[i] = 0u;
    const int skk = tid >> 3, spart = tid & 7;
    for (int uid_ = bid; uid_ < 256; uid_ += G) { const int uid = (((uid_ & 7) << 5) | ((uid_ & 255) >> 3));
        const int b = uid >> 6, h = (uid >> 2) & 15, sp = uid & 3;
        const float slope2 = exp2f(-0.5f * (float)(h + 1)) * 1.4426950408889634f;
        const size_t headoff = (size_t)(b * NH + h) * SEQ * HD;
        v4u pkA[4], pvA[4], pkB[4], pvB[4]; bf16x8 qA0, qA1, qB0, qB1; v4u opA[2], opB[2]; float lpA, lpB;
        att_prefetch(Q, K, V, headoff, b, h, sp, 0, skk, spart, w, fr, fq, pkA, pvA, qA0, qA1, O, LSE, opA, lpA);
        att_prefetch(Q, K, V, headoff, b, h, sp, 1, skk, spart, w, fr, fq, pkB, pvB, qB0, qB1, O, LSE, opB, lpB);
#pragma unroll 1
        for (int bi = 0; bi < 48; bi += 2) {
            att_block<MODE>(Q, K, V, O, LSE, lds, headoff, slope2, b, h, sp, bi, skk, spart, w, fr, fq, pkA, pvA, qA0, qA1, opA, lpA);
            att_block<MODE>(Q, K, V, O, LSE, lds, headoff, slope2, b, h, sp, bi + 1, skk, spart, w, fr, fq, pkB, pvB, qB0, qB1, opB, lpB);
        }
        asm volatile("s_waitcnt vmcnt(0)" ::: "memory");
        __syncthreads();
    }
}

#define XB_TMO      128
#define XB_XCNT(j)  (256  + 64 * (j))
#define XB_XSUB(j)  (1280 + 64 * (j))
#define XB_XGEN(j)  (2304 + 64 * (j))
#define XB_TOP      3328
#define XB_TOPGEN   3392
#define XCD_BAR_WORDS 3456
#define XB_SPIN_CAP (1u << 22)
__device__ __forceinline__ unsigned xb_ld(unsigned* p)              { return __hip_atomic_load(p, __ATOMIC_RELAXED, __HIP_MEMORY_SCOPE_AGENT); }
__device__ __forceinline__ unsigned xb_add(unsigned* p, unsigned v) { return __hip_atomic_fetch_add(p, v, __ATOMIC_RELAXED, __HIP_MEMORY_SCOPE_AGENT); }
__device__ __forceinline__ unsigned xb_xcc_id() { return (unsigned)__builtin_amdgcn_s_getreg((3 << 11) | 20) & 0xFu; }
#define XB_SPIN(cond, bar) do { unsigned _sp = 0; while (cond) { __builtin_amdgcn_s_sleep(1); \
    if ((++_sp & 255u) == 0u) { if (xb_ld(&(bar)[XB_TMO])) break; if (_sp > XB_SPIN_CAP) { atomicAdd(&(bar)[XB_TMO], 1u); break; } } } } while (0)
struct XcdBarrier { unsigned* bar; unsigned x; volatile LAS unsigned* st; };
__device__ __forceinline__ XcdBarrier xcd_barrier_post(unsigned* bar, volatile LAS unsigned* st) {
    XcdBarrier b; b.bar = bar; b.x = xb_xcc_id(); b.st = st;
    if (threadIdx.x == 0) (void)xb_add(&bar[XB_XCNT(b.x)], 1u);
    return b;
}
__device__ __forceinline__ void xcd_barrier_complete(unsigned* bar, unsigned x, unsigned& nloc, unsigned& nx) {
    const unsigned G = gridDim.x * gridDim.y * gridDim.z;
    unsigned sum, cnt, mine, sp = 0u;
    for (;;) {
        sum = 0u; cnt = 0u; mine = 0u;
#pragma unroll
        for (unsigned j = 0; j < 16; ++j) { const unsigned c = xb_ld(&bar[XB_XCNT(j)]); sum += c; cnt += (c > 0u) ? 1u : 0u; mine = (j == x) ? c : mine; }
        if (sum == G) break;
        __builtin_amdgcn_s_sleep(1);
        if ((++sp & 255u) == 0u) { if (xb_ld(&bar[XB_TMO])) break; if (sp > XB_SPIN_CAP) { atomicAdd(&bar[XB_TMO], 1u); break; } }
    }
    nloc = mine > 0u ? mine : 1u; nx = cnt > 0u ? cnt : 1u;
}
__device__ __forceinline__ void xcd_barrier(const XcdBarrier& b) {
    asm volatile("s_waitcnt vmcnt(0)" ::: "memory");
    __syncthreads();
    if (threadIdx.x == 0) {
        unsigned* bar = b.bar;
        __builtin_amdgcn_s_waitcnt(0);
        unsigned nloc = b.st[0], nx = b.st[1];
        if (nloc == 0u) { xcd_barrier_complete(bar, b.x, nloc, nx); b.st[0] = nloc; b.st[1] = nx; }
        const unsigned old = xb_add(&bar[XB_XSUB(b.x)], 1u);
        const unsigned gen = old / nloc;
        if (old + 1u == (gen + 1u) * nloc) {
            __builtin_amdgcn_fence(__ATOMIC_RELEASE, "agent");
            asm volatile("s_waitcnt vmcnt(0)" ::: "memory");
            const unsigned og = xb_add(&bar[XB_TOP], 1u);
            const unsigned tg = og / nx;
            if (og + 1u == (tg + 1u) * nx) xb_add(&bar[XB_TOPGEN], 1u);
            else XB_SPIN(xb_ld(&bar[XB_TOPGEN]) == tg, bar);
            __builtin_amdgcn_fence(__ATOMIC_ACQUIRE, "agent");
            xb_add(&bar[XB_XGEN(b.x)], 1u);
            asm volatile("s_waitcnt vmcnt(0)" ::: "memory");
        } else {
            XB_SPIN(xb_ld(&bar[XB_XGEN(b.x)]) == gen, bar);
            __builtin_amdgcn_fence(__ATOMIC_ACQUIRE, "agent");
            asm volatile("s_waitcnt vmcnt(0)" ::: "memory");
        }
    }
    __syncthreads();
}

__global__ void __launch_bounds__(NT, 2) fwd_kernel(Args a) {
    extern __shared__ __attribute__((aligned(16))) unsigned char lds_raw[];
    LAS unsigned char* lds = (LAS unsigned char*)lds_raw;
    cg::grid_group grid = cg::this_grid();
    const int G = gridDim.x, bid = blockIdx.x;
    if (threadIdx.x < 64) ((LAS unsigned*)(lds + 131072))[threadIdx.x] = 0u;
    __syncthreads();
    const XcdBarrier xbar = xcd_barrier_post((unsigned*)(a.ws + WS_CTL) + 4096, (volatile LAS unsigned*)(lds + 131072) + 8);
#define GSYNC() xcd_barrier(xbar)
#define PHASE_VARS() unsigned char* ws = opq(a.ws); float* out = opq(a.out); const int tid = opqv((int)threadIdx.x), lane = tid & 63, wave = __builtin_amdgcn_readfirstlane(tid >> 6); \
    const int gw = bid * NWAVES + wave, NGW = G * NWAVES; bf16* XN = (bf16*)(ws + WS_XN); LAS float* scr = (LAS float*)(lds + wave * 16384); (void)out; (void)lane; (void)gw; (void)NGW; (void)XN; (void)scr;

    {
        PHASE_VARS();
        { v4u* xbz = (v4u*)(ws + WS_XB); for (int i = bid * NT + tid; i < (int)(4 * MiB / 16); i += G * NT) xbz[i] = (v4u){0u, 0u, 0u, 0u}; }
        convert_layer(a, 0, ws + WS_W0, scr, gw, NGW, lane);
        const float* x = opq(a.in[0]);
        for (int m = gw; m < M; m += 2 * NGW) {
            const f32x4* xa = (const f32x4*)(x + (size_t)m * D) + lane; const f32x4* xb = (const f32x4*)(x + (size_t)(m + NGW) * D) + lane;
            f32x4 va[4], vb[4]; float sa = 0.f, sb = 0.f;
#pragma unroll
            for (int j = 0; j < 4; ++j) { va[j] = xa[64 * j]; vb[j] = xb[64 * j]; }
#pragma unroll
            for (int j = 0; j < 4; ++j) { sa += (va[j].x * va[j].x + va[j].y * va[j].y) + (va[j].z * va[j].z + va[j].w * va[j].w); sb += (vb[j].x * vb[j].x + vb[j].y * vb[j].y) + (vb[j].z * vb[j].z + vb[j].w * vb[j].w); }
            const float ra = 1.f / sqrtf(wave_sum(sa) * (1.f / D) + EPS), rb = 1.f / sqrtf(wave_sum(sb) * (1.f / D) + EPS);
            unsigned long long* oa = (unsigned long long*)(XN + (size_t)m * D) + lane; unsigned long long* ob = (unsigned long long*)(XN + (size_t)(m + NGW) * D) + lane;
#pragma unroll
            for (int j = 0; j < 4; ++j) { oa[64 * j] = (unsigned long long)pk2(va[j].x * ra, va[j].y * ra) | ((unsigned long long)pk2(va[j].z * ra, va[j].w * ra) << 32);
                ob[64 * j] = (unsigned long long)pk2(vb[j].x * rb, vb[j].y * rb) | ((unsigned long long)pk2(vb[j].z * rb, vb[j].w * rb) << 32); }
        }
    }
    grid.sync();

#pragma unroll 1
    for (int l = 0; l < DEPTH; ++l) {
        const bool isA = l < 2;
        {
            unsigned char* ws = opq(a.ws); unsigned char* wl = ws + ((l & 1) ? WS_W1 : WS_W0);
            const int N1 = (l == 3) ? D : 3 * D;
            pg8::Gemm g{(const bf16*)(ws + WS_XN), (const bf16*)(wl + WO_1), M, N1, D}; pg8::StaticOrder S; S.init(M, N1, G, bid);
            pg8::EpiBf16 E;
            E.O2 = (bf16*)(ws + WS_KV); E.cmul = isA ? 1 : 0;
            if (isA) { E.O = (bf16*)(ws + WS_G); E.ldc = D; E.split_cols = 0; E.split_stride = 0; E.hm = 0; }
            else if (l == 2) { E.O = (bf16*)(ws + WS_KV); E.ldc = D; E.split_cols = D; E.split_stride = (size_t)M * D; E.hm = 1; }
            else { E.O = (bf16*)(ws + WS_H); E.ldc = D; E.split_cols = 0; E.split_stride = 0; E.hm = 0; }
            pg8::gemm_phase<pg8::EpiBf16, pg8::StaticOrder, true, true>(lds, g, S, E);
        }
        GSYNC();
        {
            PHASE_VARS();
            if (isA) conv_phase((const bf16*)(ws + WS_G), (const bf16*)(ws + WS_KV), opq(a.in[3]) + (size_t)l * 3 * D, (bf16*)(ws + WS_H), bid, G, tid);
            else attn_fast<15>((const bf16*)(ws + WS_H), (const bf16*)(ws + WS_KV), (const bf16*)(ws + WS_KV + 64 * MiB), (bf16*)(ws + WS_H + 64 * MiB), (float*)(ws + WS_LSE), lds, bid, G, tid);
            __syncthreads();
            if (l + 1 < DEPTH) convert_layer(a, l + 1, ws + ((l & 1) ? WS_W0 : WS_W1), scr, gw, NGW, lane);
        }
        GSYNC();
#pragma unroll 1
        for (int round = 0; round < 2; ++round) {
            unsigned char* ws = opq(a.ws); unsigned char* wl = ws + ((l & 1) ? WS_W1 : WS_W0);
            pg8::Gemm g{isA ? (const bf16*)(ws + WS_H) : (const bf16*)(ws + WS_H + 64 * MiB), (const bf16*)(wl + WO_3), M, D, D};
            pg8::RoundOrder S; S.so.init(M, D, G, bid); S.round = round;
            unsigned long long* xb = (unsigned long long*)(ws + WS_XB);
            pg8::EpiRmsResRms E; E.base = (l == 0) ? opq(a.in[0]) : nullptr; E.out = opq(a.out); E.xn = (bf16*)(ws + WS_XN); E.gain = opq(a.in[1]) + (size_t)l * 4 * D + D; E.write_xn = 1; E.write_out = 0;
            E.inv_in = (const float*)(ws + WS_INV) + M; E.inv_out = (float*)(ws + WS_INV);
            E.st1.xbuf = xb; E.st1.tag = (unsigned)(l + 1);
            E.st2.xbuf = xb + (size_t)M * 4; E.st2.tag = (unsigned)(l + 1);
            pg8::gemm_phase<pg8::EpiRmsResRms, pg8::RoundOrder, false, true>(lds, g, S, E);
            __syncthreads();
        }
        GSYNC();
        {
            unsigned char* ws = opq(a.ws); unsigned char* wl = ws + ((l & 1) ? WS_W1 : WS_W0);
            pg8::Gemm g{(const bf16*)(ws + WS_XN), (const bf16*)(wl + WO_FI), M, 2 * FF, D}; pg8::StaticOrder S; S.init(M, 2 * FF, G, bid);
            pg8::EpiSwiGLU E; E.O = (bf16*)(ws + WS_H); E.ldc = FF;
            pg8::gemm_phase<pg8::EpiSwiGLU, pg8::StaticOrder, true, true>(lds, g, S, E);
        }
        GSYNC();
#pragma unroll 1
        for (int round = 0; round < 2; ++round) {
            unsigned char* ws = opq(a.ws); unsigned char* wl = ws + ((l & 1) ? WS_W1 : WS_W0);
            pg8::Gemm g{(const bf16*)(ws + WS_H), (const bf16*)(wl + WO_FO), M, D, FF};
            pg8::RoundOrder S; S.so.init(M, D, G, bid); S.round = round;
            unsigned long long* xb = (unsigned long long*)(ws + WS_XB) + (size_t)M * 8;
            pg8::EpiRmsResRms E; E.base = nullptr; E.out = opq(a.out); E.xn = (bf16*)(ws + WS_XN); E.gain = opq(a.in[1]) + (size_t)l * 4 * D + 3 * D; E.write_xn = (l + 1 < DEPTH) ? 1 : 0; E.write_out = (l + 1 < DEPTH) ? 0 : 1;
            E.inv_in = (const float*)(ws + WS_INV); E.inv_out = (float*)(ws + WS_INV) + M;
            E.st1.xbuf = xb; E.st1.tag = (unsigned)(l + 1);
            E.st2.xbuf = xb + (size_t)M * 4; E.st2.tag = (unsigned)(l + 1);
            pg8::gemm_phase<pg8::EpiRmsResRms, pg8::RoundOrder, false, true>(lds, g, S, E);
            __syncthreads();
        }
        if (l + 1 < DEPTH) GSYNC();
    }
}

extern "C" void kernel_launch(void* const* d_in, const int* in_sizes, int n_in, void* d_out, int out_size, void* d_ws, size_t ws_size, hipStream_t stream) {
    static int grid = 0;
    if (grid == 0) {
        if (n_in != 11 || ws_size < WS_END) { fprintf(stderr, "kernel_launch: unexpected n_in %d / ws_size %zu\n", n_in, ws_size); grid = -1; return; }
        int dev = 0, cus = 0, per_cu = 0;
        hipGetDevice(&dev);
        hipDeviceGetAttribute(&cus, hipDeviceAttributeMultiprocessorCount, dev);
        hipFuncSetAttribute((const void*)fwd_kernel, hipFuncAttributeMaxDynamicSharedMemorySize, LDS_BYTES);
        if (hipOccupancyMaxActiveBlocksPerMultiprocessor(&per_cu, (const void*)fwd_kernel, NT, LDS_BYTES) != hipSuccess || per_cu < 1) per_cu = 1;
        (void)hipGetLastError();
        grid = cus * per_cu;
        if (grid >= 256) grid = 256;
    }
    if (grid < 0) return;
    if (hipMemsetAsync((char*)d_ws + WS_CTL, 0, 64 * 1024, stream) != hipSuccess) { fprintf(stderr, "memset failed\n"); return; }
    Args a{};
    for (int i = 0; i < 11; ++i) a.in[i] = (const float*)d_in[i];
    a.out = (float*)d_out; a.ws = (unsigned char*)d_ws;
    void* args[] = {&a};
    hipError_t e = hipLaunchCooperativeKernel((const void*)fwd_kernel, dim3(grid), dim3(NT), args, LDS_BYTES, stream);
    if (e != hipSuccess) fprintf(stderr, "cooperative launch failed: %s (grid %d)\n", hipGetErrorString(e), grid);
}
```

```cpp
#include <hip/hip_runtime.h>
#include <hip/hip_cooperative_groups.h>
#include <cstdio>
#include <cstdint>
namespace cg = cooperative_groups;

namespace pg8 {
#define PG8_LAS __attribute__((address_space(3)))
typedef unsigned short bf16_t;
typedef short bf16x8 __attribute__((ext_vector_type(8)));
typedef float f32x4 __attribute__((ext_vector_type(4)));
typedef unsigned u32x4 __attribute__((ext_vector_type(4)));
constexpr int BM = 256, BK = 64, HALF = 128, HTB = HALF * BK * 2, STAGE_BYTES = 8 * HTB, NXCD = 8, WGM = 8;

__host__ __device__ __forceinline__ int lds_byte(int r, int c) { const int st = (r >> 4) * 2 + (c >> 5), rr = r & 15, cc = c & 31, ob = rr * 64 + cc * 2; return st * 1024 + (ob ^ (((ob >> 9) & 1) << 5)); }
__host__ __device__ __forceinline__ void stage_rc(int b, int& R, int& C) { const int st = b / 1024, sb = b % 1024, swz = sb ^ (((sb >> 9) & 1) << 5); R = (st >> 1) * 16 + swz / 64; C = (st & 1) * 32 + (swz % 64) / 2; }
__host__ __device__ __forceinline__ int perm32(int rho) { const int n = rho >> 4, i = rho & 15; return 8 * (i >> 2) + 4 * n + (i & 3); }

struct Unit { int pm, pn; };
struct Gemm { const bf16_t* A; const bf16_t* Bt; int M, N, K; };

struct StaticOrder {
    int nM, nN, nwg, G, c;
    __host__ __device__ void init(int M, int N, int G_, int c_) { nM = M / BM; nN = N / BM; nwg = nM * nN; G = G_; c = c_; }
    __host__ __device__ bool next(int i, Unit& u) const { return at(i, u); }
    __host__ __device__ bool at(int i, Unit& u) const {
        const long L = (long)i * G + c; if (L >= nwg) return false;
        int wgid = (int)L; { const int q = nwg / NXCD, r = nwg % NXCD, xcd = wgid % NXCD, off = wgid / NXCD; wgid = (xcd < r ? xcd * (q + 1) : r * (q + 1) + (xcd - r) * q) + off; }
        const int nig = WGM * nN, gid = wgid / nig, fm = gid * WGM, gsz = (nM - fm) < WGM ? (nM - fm) : WGM;
        u.pm = fm + ((wgid % nig) % gsz); u.pn = (wgid % nig) / gsz; return true;
    }
    __device__ __forceinline__ void a_ready(const Unit&) const {}
    __device__ __forceinline__ void done(const Unit&) const {}
};

struct RoundOrder {
    StaticOrder so; int round;
    __device__ __forceinline__ bool next(int i, Unit& u) const { if (i > 0) return false; return so.at(round, u); }
    __device__ __forceinline__ void a_ready(const Unit&) const {}
    __device__ __forceinline__ void done(const Unit&) const {}
};
__device__ __forceinline__ unsigned cvt_pk_bf16(float lo, float hi) { unsigned r; asm volatile("v_cvt_pk_bf16_f32 %0, %1, %2" : "=v"(r) : "v"(lo), "v"(hi)); return r; }

struct EpiBf16 {
    static constexpr bool PERM = true, AFTER_DRAIN = false;
    bf16_t* O; int ldc; int split_cols; size_t split_stride; int hm; bf16_t* O2; int cmul;
    __device__ __forceinline__ void operator()(const f32x4 (&acc)[2][2][4][2], const Unit& u, int wr, int wc, int fr, int fq) const {
        if (cmul && u.pn >= 4) {
            const int row0 = u.pm * BM + wr * 64 + fr, col0 = (u.pn - 4) * HALF + wc * 32 + 8 * fq;
#pragma unroll
            for (int ai = 0; ai < 2; ++ai)
#pragma unroll
                for (int m = 0; m < 4; ++m) { const f32x4 v0 = acc[ai][0][m][0] * acc[ai][1][m][0], v1 = acc[ai][0][m][1] * acc[ai][1][m][1];
                    u32x4 w; w.x = cvt_pk_bf16(v0[0], v0[1]); w.y = cvt_pk_bf16(v0[2], v0[3]); w.z = cvt_pk_bf16(v1[0], v1[1]); w.w = cvt_pk_bf16(v1[2], v1[3]);
                    *(u32x4*)(O2 + (size_t)(row0 + ai * HALF + m * 16) * 1024 + col0) = w; }
            return;
        }
        const int row0 = u.pm * BM + wr * 64 + fr; int colt = u.pn * BM; bf16_t* base = O; int t = 0;
        if (split_cols) { t = colt / split_cols; base += (size_t)t * split_stride; colt -= t * split_cols; }
        const int col0 = colt + wc * 32 + 8 * fq;
        const bool headmajor = hm && t < 2;
#pragma unroll
        for (int ai = 0; ai < 2; ++ai)
#pragma unroll
            for (int m = 0; m < 4; ++m) { const int row = row0 + ai * HALF + m * 16;
                bf16_t* rowp = headmajor ? base + ((size_t)((row >> 13) * 16 + (col0 >> 6)) * 8192 + (row & 8191)) * 64 + (col0 & 63) : base + (size_t)row * ldc + col0;
                const size_t bjstep = headmajor ? (size_t)2 * 8192 * 64 : (size_t)HALF;
#pragma unroll
                for (int bj = 0; bj < 2; ++bj) { const f32x4 v0 = acc[ai][bj][m][0], v1 = acc[ai][bj][m][1];
                    u32x4 w; w.x = cvt_pk_bf16(v0[0], v0[1]); w.y = cvt_pk_bf16(v0[2], v0[3]); w.z = cvt_pk_bf16(v1[0], v1[1]); w.w = cvt_pk_bf16(v1[2], v1[3]);
                    *(u32x4*)(rowp + bj * bjstep) = w; } }
    }
};
__device__ __forceinline__ float silu_mul(float g, float u) { return g * u * __builtin_amdgcn_rcpf(1.0f + __expf(-g)); }
struct EpiSwiGLU {
    static constexpr bool PERM = true, AFTER_DRAIN = false;
    bf16_t* O; int ldc;
    __device__ __forceinline__ void operator()(const f32x4 (&acc)[2][2][4][2], const Unit& u, int wr, int wc, int fr, int fq) const {
        const int row0 = u.pm * BM + wr * 64 + fr; const int col0 = u.pn * HALF + wc * 32 + 8 * fq;
#pragma unroll
        for (int ai = 0; ai < 2; ++ai)
#pragma unroll
            for (int m = 0; m < 4; ++m) { bf16_t* rowp = O + (size_t)(row0 + ai * HALF + m * 16) * ldc + col0;
                const f32x4 g0 = acc[ai][0][m][0], g1 = acc[ai][0][m][1], u0 = acc[ai][1][m][0], u1 = acc[ai][1][m][1];
                typedef float f32x2 __attribute__((ext_vector_type(2)));
                u32x4 w;
#define PG8_SILU2(G, U, A, B) ([&]() { const f32x2 gg = (f32x2){G[A], G[B]}, uu = (f32x2){U[A], U[B]}; const f32x2 t = gg * (-1.4426950408889634f); \
                    f32x2 e; e.x = __builtin_amdgcn_exp2f(t.x); e.y = __builtin_amdgcn_exp2f(t.y); const f32x2 d = e + 1.0f; f32x2 r; r.x = __builtin_amdgcn_rcpf(d.x); r.y = __builtin_amdgcn_rcpf(d.y); \
                    const f32x2 o = (gg * uu) * r; return cvt_pk_bf16(o.x, o.y); }())
                w.x = PG8_SILU2(g0, u0, 0, 1); w.y = PG8_SILU2(g0, u0, 2, 3); w.z = PG8_SILU2(g1, u1, 0, 1); w.w = PG8_SILU2(g1, u1, 2, 3);
#undef PG8_SILU2
                *(u32x4*)rowp = w; }
    }
};

struct RmsXchg {
    unsigned long long* xbuf;
    unsigned tag;
    __device__ __forceinline__ void run(const f32x4 (&v)[2][2][4][2], const Unit& u, int wr, int wc, int fr, int fq, PG8_LAS unsigned char* lds, int wid, int lane) const {
        PG8_LAS float* P = (PG8_LAS float*)lds;
        PG8_LAS float* S = (PG8_LAS float*)(lds + 4096);
#pragma unroll
        for (int ai = 0; ai < 2; ++ai)
#pragma unroll
            for (int m = 0; m < 4; ++m) {
                float q = 0.f;
#pragma unroll
                for (int bj = 0; bj < 2; ++bj)
#pragma unroll
                    for (int n = 0; n < 2; ++n) { const f32x4 x = v[ai][bj][m][n]; q += (x[0] * x[0] + x[1] * x[1]) + (x[2] * x[2] + x[3] * x[3]); }
                q += __shfl_xor(q, 16); q += __shfl_xor(q, 32);
                if (fq == 0) P[(ai * HALF + wr * 64 + m * 16 + fr) * 4 + wc] = q;
            }
        asm volatile("s_waitcnt lgkmcnt(0)" ::: "memory"); __builtin_amdgcn_s_barrier(); asm volatile("" ::: "memory");
        const int row = wid * 32 + (lane & 31);
        unsigned long long* slot = xbuf + (size_t)(u.pm * BM + row) * 4;
        if (lane < 32) { const f32x4 p = *(const PG8_LAS f32x4*)(P + row * 4); const float t = (p[0] + p[1]) + (p[2] + p[3]);
            __hip_atomic_store(slot + u.pn, ((unsigned long long)tag << 32) | (unsigned long long)__builtin_bit_cast(unsigned, t), __ATOMIC_RELAXED, __HIP_MEMORY_SCOPE_AGENT); }
        float tot = 0.f; unsigned sp = 0u;
        for (;;) {
            bool ok = true; tot = 0.f;
            if (lane < 32) {
#pragma unroll
                for (int k = 0; k < 4; ++k) { const unsigned long long wv = __hip_atomic_load(slot + k, __ATOMIC_RELAXED, __HIP_MEMORY_SCOPE_AGENT); ok = ok && ((unsigned)(wv >> 32) == tag); tot += __builtin_bit_cast(float, (unsigned)wv); }
            }
            if (__builtin_amdgcn_ballot_w64(!ok) == 0ull) break;
            if (++sp > (1u << 22)) break;
            __builtin_amdgcn_s_sleep(1);
        }
        if (lane < 32) S[row] = 1.0f / sqrtf(tot * (1.0f / 1024.0f) + 1e-6f);
        asm volatile("s_waitcnt lgkmcnt(0)" ::: "memory"); __builtin_amdgcn_s_barrier(); asm volatile("" ::: "memory");
    }
};
struct EpiRmsResRms {
    static constexpr bool PERM = true, AFTER_DRAIN = true;
    const float* base; float* out; bf16_t* xn; const float* gain; const float* inv_in; float* inv_out; RmsXchg st1, st2; int write_xn, write_out;
    __device__ __forceinline__ void fused(f32x4 (&acc)[2][2][4][2], const Unit& u, int wr, int wc, int fr, int fq, PG8_LAS unsigned char* lds, int wid, int lane) const {
        const PG8_LAS float* S = (const PG8_LAS float*)(lds + 4096);
        const int col0 = u.pn * BM + wc * 32 + 8 * fq;
        u32x4 pre[4][2]; float ivs[4], ivs1[4];
        if (!base) {
#pragma unroll
            for (int m = 0; m < 4; ++m) { const int r = wr * 64 + m * 16 + fr; const size_t off = (size_t)(u.pm * BM + r) * 1024 + col0; ivs[m] = inv_in[u.pm * BM + r]; ivs1[m] = inv_in[u.pm * BM + HALF + r];
#pragma unroll
                for (int bj = 0; bj < 2; ++bj) pre[m][bj] = *(const u32x4*)(xn + off + bj * HALF); }
        }
        f32x4 gq[2][2];
#pragma unroll
        for (int bj = 0; bj < 2; ++bj) { gq[bj][0] = *(const f32x4*)(gain + col0 + bj * HALF); gq[bj][1] = *(const f32x4*)(gain + col0 + bj * HALF + 4); }
        st1.run(acc, u, wr, wc, fr, fq, lds, wid, lane);
#pragma unroll
        for (int ai = 0; ai < 2; ++ai)
#pragma unroll
            for (int m = 0; m < 4; ++m) { const int r = ai * HALF + wr * 64 + m * 16 + fr; const float rs = S[r]; const size_t off = (size_t)(u.pm * BM + r) * 1024 + col0;
#pragma unroll
                for (int bj = 0; bj < 2; ++bj) { f32x4 b0, b1;
                    if (base) { b0 = *(const f32x4*)(base + off + bj * HALF); b1 = *(const f32x4*)(base + off + bj * HALF + 4); }
                    else { const u32x4 w = (ai == 0) ? pre[m][bj] : *(const u32x4*)(xn + off + bj * HALF); const float iv = (ai == 0) ? ivs[m] : ivs1[m];
                        b0 = (f32x4){__builtin_bit_cast(float, w.x << 16), __builtin_bit_cast(float, w.x & 0xffff0000u), __builtin_bit_cast(float, w.y << 16), __builtin_bit_cast(float, w.y & 0xffff0000u)} * iv;
                        b1 = (f32x4){__builtin_bit_cast(float, w.z << 16), __builtin_bit_cast(float, w.z & 0xffff0000u), __builtin_bit_cast(float, w.w << 16), __builtin_bit_cast(float, w.w & 0xffff0000u)} * iv; }
                    acc[ai][bj][m][0] = b0 + acc[ai][bj][m][0] * rs * gq[bj][0]; acc[ai][bj][m][1] = b1 + acc[ai][bj][m][1] * rs * gq[bj][1]; }
                asm volatile("" : "+v"(acc[ai][0][m][0]), "+v"(acc[ai][0][m][1]), "+v"(acc[ai][1][m][0]), "+v"(acc[ai][1][m][1])); }
        if (write_xn) st2.run(acc, u, wr, wc, fr, fq, lds, wid, lane);
#pragma unroll
        for (int ai = 0; ai < 2; ++ai)
#pragma unroll
            for (int m = 0; m < 4; ++m) { const int r = ai * HALF + wr * 64 + m * 16 + fr; const float rs = S[r]; const size_t off = (size_t)(u.pm * BM + r) * 1024 + col0;
#pragma unroll
                for (int bj = 0; bj < 2; ++bj) { const f32x4 x0 = acc[ai][bj][m][0], x1 = acc[ai][bj][m][1];
                    if (write_out) { *(f32x4*)(out + off + bj * HALF) = x0; *(f32x4*)(out + off + bj * HALF + 4) = x1; }
                    if (write_xn) { const f32x4 o0 = x0 * rs, o1 = x1 * rs; u32x4 w; w.x = cvt_pk_bf16(o0[0], o0[1]); w.y = cvt_pk_bf16(o0[2], o0[3]); w.z = cvt_pk_bf16(o1[0], o1[1]); w.w = cvt_pk_bf16(o1[2], o1[3]);
                        *(u32x4*)(xn + off + bj * HALF) = w; } }
                asm volatile("" ::: "memory"); }
        if (write_xn && u.pn == 0 && lane < 32) inv_out[u.pm * BM + wid * 32 + lane] = 1.0f / S[wid * 32 + lane];
    }
};

template <class Epi, class Sched, bool ALIGN_EPI = false, bool SP2 = false>
__device__ __forceinline__ void gemm_phase(PG8_LAS unsigned char* lds, const Gemm g, const Sched& S, const Epi& E) {
    int tid = threadIdx.x; asm volatile("" : "+v"(tid));
    const int wid = __builtin_amdgcn_readfirstlane(tid >> 6), lane = tid & 63, wr = wid >> 2, wc = wid & 3, fr = lane & 15, fq = lane >> 4;
    const int K = g.K, nt = K / BK;
    unsigned voffA[2], voffB[2];
#pragma unroll
    for (int i = 0; i < 2; ++i) { int R, C; stage_rc(tid * 16 + i * 8192, R, C); const int Rb = Epi::PERM ? ((R & ~31) + perm32(R & 31)) : R;
        voffA[i] = (unsigned)(R * K + C) * 2u; voffB[i] = (unsigned)(Rb * K + C) * 2u; }
    const size_t kstep = (size_t)(BK * 2);
    const size_t hstep = (size_t)HALF * K * 2;
    const size_t tstep = 2 * hstep;
    const unsigned ldsw = (unsigned)wid * 1024u;
    const int aoff = lds_byte(wr * 64 + fr, fq * 8), boff = lds_byte(wc * 32 + fr, fq * 8);
#define PG8_SA(b, h) (((b) * 2 + (h)) * HTB)
#define PG8_SB(b, h) ((4 + (b) * 2 + (h)) * HTB)
#define PG8_STAGE(bufoff, gbase, voff) do { _Pragma("unroll") for (int _i = 0; _i < 2; ++_i) \
        __builtin_amdgcn_global_load_lds((const unsigned*)((const char*)(gbase) + (voff)[_i]), (PG8_LAS unsigned*)(lds + (bufoff) + ldsw + _i * 8192), 16, 0, 0); } while (0)
#define PG8_LDA(dst, b, h) do { _Pragma("unroll") for (int m = 0; m < 4; ++m) _Pragma("unroll") for (int k = 0; k < 2; ++k) dst[m][k] = *(const PG8_LAS bf16x8*)(lds + PG8_SA(b, h) + aoff + m * 2048 + k * 1024); } while (0)
#define PG8_LDB(dst, b, h) do { _Pragma("unroll") for (int n = 0; n < 2; ++n) _Pragma("unroll") for (int k = 0; k < 2; ++k) dst[n][k] = *(const PG8_LAS bf16x8*)(lds + PG8_SB(b, h) + boff + n * 2048 + k * 1024); } while (0)
#define PG8_MMA(ai, bj, At, Bt) do { __builtin_amdgcn_s_setprio(1); _Pragma("unroll") for (int m = 0; m < 4; ++m) _Pragma("unroll") for (int n = 0; n < 2; ++n) _Pragma("unroll") for (int k = 0; k < 2; ++k) \
        acc[ai][bj][m][n] = __builtin_amdgcn_mfma_f32_16x16x32_bf16(Bt[n][k], At[m][k], acc[ai][bj][m][n], 0, 0, 0); __builtin_amdgcn_s_setprio(0); } while (0)
#define PG8_WAIT_V(n) asm volatile("s_waitcnt vmcnt(" #n ")" ::: "memory")
#define PG8_WAIT_L(n) asm volatile("s_waitcnt lgkmcnt(" #n ")" ::: "memory")
#define PG8_BAR __builtin_amdgcn_s_barrier()
#define PG8_SCHED __builtin_amdgcn_sched_barrier(0)
    Unit cur, nxt; int ui = 0;
    if (!S.next(0, cur)) return;
    f32x4 acc[2][2][4][2];
#pragma unroll
    for (int a = 0; a < 2; ++a)
#pragma unroll
        for (int b = 0; b < 2; ++b)
#pragma unroll
            for (int m = 0; m < 4; ++m)
#pragma unroll
                for (int n = 0; n < 2; ++n) acc[a][b][m][n] = (f32x4){0.f, 0.f, 0.f, 0.f};
    bf16x8 At[4][2], B0[2][2], B1[2][2];
    const char* cA = (const char*)g.A + (size_t)cur.pm * tstep; const char* cB = (const char*)g.Bt + (size_t)cur.pn * tstep;
    S.a_ready(cur);
    if constexpr (SP2) {
        PG8_STAGE(PG8_SB(0, 0), cB, voffB); PG8_STAGE(PG8_SB(0, 1), cB + hstep, voffB); PG8_STAGE(PG8_SA(0, 0), cA, voffA); PG8_STAGE(PG8_SA(0, 1), cA + hstep, voffA);
        if (wr == 1) PG8_BAR;
        PG8_WAIT_V(2); PG8_BAR;
        PG8_STAGE(PG8_SB(1, 0), cB + kstep, voffB); PG8_STAGE(PG8_SA(1, 0), cA + kstep, voffA); PG8_STAGE(PG8_SB(1, 1), cB + hstep + kstep, voffB);
        PG8_WAIT_V(6); PG8_BAR;
    } else {
        PG8_STAGE(PG8_SB(0, 0), cB, voffB); PG8_STAGE(PG8_SA(0, 0), cA, voffA); PG8_STAGE(PG8_SB(0, 1), cB + hstep, voffB); PG8_STAGE(PG8_SA(0, 1), cA + hstep, voffA);
        if (wr == 1) PG8_BAR;
        PG8_WAIT_V(4); PG8_BAR;
        PG8_STAGE(PG8_SB(1, 0), cB + kstep, voffB); PG8_STAGE(PG8_SA(1, 0), cA + kstep, voffA); PG8_STAGE(PG8_SB(1, 1), cB + hstep + kstep, voffB);
        PG8_WAIT_V(6); PG8_BAR;
    }
    for (;;) {
        const bool has_next = S.next(ui + 1, nxt);
        const char* nA = has_next ? (const char*)g.A + (size_t)nxt.pm * tstep : cA; const char* nB = has_next ? (const char*)g.Bt + (size_t)nxt.pn * tstep : cB;
        for (int t = 0; t < nt; t += 2) {
            const bool last = (t == nt - 2);
            const char* a1 = cA + (size_t)(t + 1) * kstep;
            const char* a2 = last ? nA : cA + (size_t)(t + 2) * kstep; const char* b2 = last ? nB : cB + (size_t)(t + 2) * kstep;
            const char* a3 = a2 + kstep; const char* b3 = b2 + kstep;
            if (last && has_next) S.a_ready(nxt);
            if constexpr (SP2) {
            PG8_LDB(B0, 0, 0); PG8_LDB(B1, 0, 1); PG8_SCHED; PG8_LDA(At, 0, 0); PG8_STAGE(PG8_SA(1, 1), a1 + hstep, voffA);
            PG8_WAIT_V(8); PG8_WAIT_L(0); PG8_BAR; PG8_MMA(0, 0, At, B0); PG8_MMA(0, 1, At, B1); PG8_BAR; PG8_SCHED;
            PG8_LDA(At, 0, 1); PG8_STAGE(PG8_SB(0, 0), b2, voffB); PG8_STAGE(PG8_SB(0, 1), b2 + hstep, voffB); PG8_STAGE(PG8_SA(0, 0), a2, voffA);
            PG8_WAIT_V(8); PG8_WAIT_L(0); PG8_BAR; PG8_MMA(1, 0, At, B0); PG8_MMA(1, 1, At, B1); PG8_BAR; PG8_SCHED;
            PG8_LDB(B0, 1, 0); PG8_LDB(B1, 1, 1); PG8_SCHED; PG8_LDA(At, 1, 0); PG8_STAGE(PG8_SA(0, 1), a2 + hstep, voffA);
            PG8_WAIT_V(8); PG8_WAIT_L(0); PG8_BAR; PG8_MMA(0, 0, At, B0); PG8_MMA(0, 1, At, B1); PG8_BAR; PG8_SCHED;
            PG8_LDA(At, 1, 1); PG8_STAGE(PG8_SB(1, 0), b3, voffB); PG8_STAGE(PG8_SB(1, 1), b3 + hstep, voffB); PG8_STAGE(PG8_SA(1, 0), a3, voffA);
            PG8_WAIT_V(8); PG8_WAIT_L(0); PG8_BAR; PG8_MMA(1, 0, At, B0); PG8_MMA(1, 1, At, B1); PG8_BAR; PG8_SCHED;
            } else {
            PG8_LDB(B0, 0, 0); PG8_SCHED; PG8_LDA(At, 0, 0); PG8_STAGE(PG8_SA(1, 1), a1 + hstep, voffA);
            PG8_WAIT_L(8); PG8_BAR; PG8_WAIT_L(0); PG8_MMA(0, 0, At, B0); PG8_BAR; PG8_SCHED;
            PG8_LDB(B1, 0, 1); PG8_STAGE(PG8_SB(0, 0), b2, voffB);
            PG8_BAR; PG8_WAIT_L(0); PG8_MMA(0, 1, At, B1); PG8_BAR;
            PG8_LDA(At, 0, 1); PG8_STAGE(PG8_SA(0, 0), a2, voffA);
            PG8_BAR; PG8_WAIT_L(0); PG8_MMA(1, 0, At, B0); PG8_BAR; PG8_SCHED;
            PG8_STAGE(PG8_SB(0, 1), b2 + hstep, voffB);
            PG8_WAIT_V(6); PG8_BAR; PG8_MMA(1, 1, At, B1); PG8_BAR;
            PG8_LDB(B0, 1, 0); PG8_SCHED; PG8_LDA(At, 1, 0); PG8_STAGE(PG8_SA(0, 1), a2 + hstep, voffA);
            PG8_WAIT_L(8); PG8_BAR; PG8_WAIT_L(0); PG8_MMA(0, 0, At, B0); PG8_BAR; PG8_SCHED;
            PG8_LDB(B1, 1, 1); PG8_STAGE(PG8_SB(1, 0), b3, voffB);
            PG8_BAR; PG8_WAIT_L(0); PG8_MMA(0, 1, At, B1); PG8_BAR;
            PG8_LDA(At, 1, 1); PG8_STAGE(PG8_SA(1, 0), a3, voffA);
            PG8_BAR; PG8_WAIT_L(0); PG8_MMA(1, 0, At, B0); PG8_BAR; PG8_SCHED;
            PG8_STAGE(PG8_SB(1, 1), b3 + hstep, voffB);
            PG8_WAIT_V(6); PG8_BAR; PG8_MMA(1, 1, At, B1); PG8_BAR;
            }
        }
        if constexpr (ALIGN_EPI) { if (wr == 0) PG8_BAR; }
        if constexpr (!Epi::AFTER_DRAIN) { E(acc, cur, wr, wc, fr, fq); S.done(cur); }
        if (!has_next) break;
#pragma unroll
        for (int a = 0; a < 2; ++a)
#pragma unroll
            for (int b = 0; b < 2; ++b)
#pragma unroll
                for (int m = 0; m < 4; ++m)
#pragma unroll
                    for (int n = 0; n < 2; ++n) acc[a][b][m][n] = (f32x4){0.f, 0.f, 0.f, 0.f};
        cur = nxt; cA = nA; cB = nB; ++ui;
        if constexpr (ALIGN_EPI) { if (wr == 1) PG8_BAR; }
    }
    PG8_WAIT_V(0);
    if constexpr (!ALIGN_EPI) { if (wr == 0) PG8_BAR; }
    PG8_BAR;
    if constexpr (Epi::AFTER_DRAIN) { E.fused(acc, cur, wr, wc, fr, fq, lds, wid, lane); S.done(cur); }
#undef PG8_SA
#undef PG8_SB
#undef PG8_STAGE
#undef PG8_LDA
#undef PG8_LDB
#undef PG8_MMA
#undef PG8_WAIT_V
#undef PG8_WAIT_L
#undef PG8_BAR
#undef PG8_SCHED
}
}

#define LAS __attribute__((address_space(3)))
typedef unsigned short bf16;
typedef unsigned v4u __attribute__((ext_vector_type(4)));
typedef unsigned v2u __attribute__((ext_vector_type(2)));
typedef float f32x4 __attribute__((ext_vector_type(4)));
constexpr int NWAVES = 8, NT = 512;
constexpr int BATCH = 4, SEQ = 8192, D = 1024, M = BATCH * SEQ, NH = 16, HD = 64, FF = 2816, DEPTH = 4;
constexpr float EPS = 1e-6f;
constexpr size_t MiB = 1u << 20;
constexpr size_t WS_CTL = 0, WS_LSE = 1 * MiB, WS_W0 = 4 * MiB, WS_W1 = 29 * MiB, WS_XN = 54 * MiB, WS_G = 118 * MiB, WS_KV = 182 * MiB, WS_H = 310 * MiB, WS_XB = 486 * MiB, WS_INV = 490 * MiB, WS_END = 491 * MiB;
constexpr int CW_SEAM = 16384, SEAM_BANK = 128 * 64;
constexpr size_t WO_1 = 0, WO_3 = 6 * MiB, WO_FI = 8 * MiB, WO_FO = 19 * MiB;
constexpr int LDS_BYTES = 131072 + 1024;

struct Args { const float* in[11]; float* out; unsigned char* ws; };

__device__ __forceinline__ unsigned f2bf(float f) { unsigned u = __builtin_bit_cast(unsigned, f); return (u + 0x7fffu + ((u >> 16) & 1u)) >> 16; }
__device__ __forceinline__ unsigned pk2(float lo, float hi) { return f2bf(lo) | (f2bf(hi) << 16); }
__device__ __forceinline__ float bflo(unsigned w) { return __builtin_bit_cast(float, w << 16); }
__device__ __forceinline__ float bfhi(unsigned w) { return __builtin_bit_cast(float, w & 0xffff0000u); }
__device__ __forceinline__ float wave_sum(float v) {
#pragma unroll
    for (int o = 1; o < 64; o <<= 1) v += __shfl_xor(v, o);
    return v;
}
__device__ __forceinline__ float wave_max(float v) {
#pragma unroll
    for (int o = 1; o < 64; o <<= 1) v = fmaxf(v, __shfl_xor(v, o));
    return v;
}
#define LDS_WAIT() asm volatile("s_waitcnt lgkmcnt(0)" ::: "memory")
template <class T> __device__ __forceinline__ T* opq(T* p) { size_t z = 0; asm volatile("" : "+s"(z)); return (T*)((unsigned char*)p + z); }
__device__ __forceinline__ int opqv(int v) { asm volatile("" : "+v"(v)); return v; }

__device__ __forceinline__ void tr_item(const float* W, int K, int N, const float* gain, float scale, bf16* WT, int swiglu, int row_off, LAS float* scr, int item, int lane) {
    const int nblk = N / 32, kb = item / nblk, nb = item % nblk, k0 = 64 * kb, n0 = 32 * nb;
    {
        const int kq = lane >> 3, n4 = (lane & 7) * 4;
        f32x4 wv[8];
#pragma unroll
        for (int i = 0; i < 8; ++i) wv[i] = *(const f32x4*)(W + (size_t)(k0 + 8 * i + kq) * N + n0 + n4);
#pragma unroll
        for (int i = 0; i < 8; ++i) { const int kk = 8 * i + kq; const float gk = gain ? gain[k0 + kk] * scale : scale;
            scr[kk * 33 + n4 + 0] = wv[i][0] * gk; scr[kk * 33 + n4 + 1] = wv[i][1] * gk; scr[kk * 33 + n4 + 2] = wv[i][2] * gk; scr[kk * 33 + n4 + 3] = wv[i][3] * gk; }
    }
    LDS_WAIT(); asm volatile("" ::: "memory");
    int drow0 = n0;
    if (swiglu == 1) drow0 = (n0 < FF) ? ((n0 >> 7) * 256 + (n0 & 127)) : (((n0 - FF) >> 7) * 256 + 128 + ((n0 - FF) & 127));
    if (swiglu == 2) drow0 = (n0 < D) ? n0 : ((n0 < 2 * D) ? (D + ((n0 - D) >> 7) * 256 + ((n0 - D) & 127)) : (D + ((n0 - 2 * D) >> 7) * 256 + 128 + ((n0 - 2 * D) & 127)));
    drow0 += row_off;
    const int c = lane & 7;
#pragma unroll
    for (int j = 0; j < 4; ++j) { const int n = (lane >> 3) + 8 * j; const LAS float* s = scr + (8 * c) * 33 + n;
        v4u o; o.x = pk2(s[0 * 33], s[1 * 33]); o.y = pk2(s[2 * 33], s[3 * 33]); o.z = pk2(s[4 * 33], s[5 * 33]); o.w = pk2(s[6 * 33], s[7 * 33]);
        *(v4u*)(WT + (size_t)(drow0 + n) * K + k0 + 8 * c) = o; }
    LDS_WAIT(); asm volatile("" ::: "memory");
}
__device__ __forceinline__ void convert_layer(const Args& a, int l, unsigned char* wbuf, LAS float* scr, int gw, int NGW, int lane) {
    const float* ng = a.in[1] + (size_t)l * 4 * D;
    bf16* W1 = (bf16*)(wbuf + WO_1); bf16* W3 = (bf16*)(wbuf + WO_3); bf16* WFI = (bf16*)(wbuf + WO_FI); bf16* WFO = (bf16*)(wbuf + WO_FO);
    const int n0 = (l < 2) ? 1536 : (l == 2 ? 1024 : 0), n1 = (l < 2) ? 0 : 512, n2 = 512, n3 = 2816, n4 = 1408;
    const int total = n0 + n1 + n2 + n3 + n4;
    for (int it = gw; it < total; it += NGW) {
        int r = it;
        if (r < n0) { if (l < 2) tr_item(a.in[2] + (size_t)l * D * 3 * D, D, 3 * D, ng, 1.f, W1, 2, 0, scr, r, lane);
                      else tr_item(a.in[6], D, 2 * D, a.in[5], 1.f, W1, 0, 0, scr, r, lane); continue; } r -= n0;
        if (r < n1) { tr_item(a.in[7] + (size_t)(l - 2) * D * D, D, D, ng, 0.125f * 1.4426950408889634f, W1, 0, (l == 2) ? 2 * D : 0, scr, r, lane); continue; } r -= n1;
        if (r < n2) { tr_item((l < 2) ? a.in[4] + (size_t)l * D * D : a.in[8] + (size_t)(l - 2) * D * D, D, D, nullptr, 1.f, W3, 0, 0, scr, r, lane); continue; } r -= n2;
        if (r < n3) { tr_item(a.in[9] + (size_t)l * D * 2 * FF, D, 2 * FF, ng + 2 * D, 1.f, WFI, 1, 0, scr, r, lane); continue; } r -= n3;
        tr_item(a.in[10] + (size_t)l * FF * D, FF, D, nullptr, 1.f, WFO, 0, 0, scr, r, lane);
    }
}
__device__ __forceinline__ void unpack8(const v4u w, float (&f)[8]) { f[0] = bflo(w.x); f[1] = bfhi(w.x); f[2] = bflo(w.y); f[3] = bfhi(w.y); f[4] = bflo(w.z); f[5] = bfhi(w.z); f[6] = bflo(w.w); f[7] = bfhi(w.w); }
__device__ __forceinline__ void conv_phase(const bf16* Bg, const bf16* U, const float* wconv, bf16* Aout, int bid, int G, int tid) {
    const int cgp = tid & 127, rc = tid >> 7, c0 = cgp * 8;
    float w0[8], w1[8], w2[8];
#pragma unroll
    for (int e = 0; e < 8; ++e) { w0[e] = wconv[c0 + e]; w1[e] = wconv[D + c0 + e]; w2[e] = wconv[2 * D + c0 + e]; }
    for (int it = bid; it < M / 128; it += G) {
        const int row0 = it * 128 + rc * 32;
        float um2[8], um1[8];
        if ((row0 & (SEQ - 1)) == 0) {
#pragma unroll
            for (int e = 0; e < 8; ++e) { um2[e] = 0.f; um1[e] = 0.f; }
        } else { unpack8(*(const v4u*)(U + (size_t)(row0 - 2) * D + c0), um2); unpack8(*(const v4u*)(U + (size_t)(row0 - 1) * D + c0), um1); }
#pragma unroll 4
        for (int r = 0; r < 32; ++r) {
            float b[8], u[8], o[8];
            unpack8(*(const v4u*)(Bg + (size_t)(row0 + r) * D + c0), b); unpack8(*(const v4u*)(U + (size_t)(row0 + r) * D + c0), u);
#pragma unroll
            for (int e = 0; e < 8; ++e) { o[e] = b[e] * (w0[e] * um2[e] + w1[e] * um1[e] + w2[e] * u[e]); um2[e] = um1[e]; um1[e] = u[e]; }
            v4u w; w.x = pk2(o[0], o[1]); w.y = pk2(o[2], o[3]); w.z = pk2(o[4], o[5]); w.w = pk2(o[6], o[7]);
            *(v4u*)(Aout + (size_t)(row0 + r) * D + c0) = w;
        }
    }
}
typedef short bf16x8 __attribute__((ext_vector_type(8)));
typedef short s16x4 __attribute__((ext_vector_type(4)));
constexpr int KSTR = 144, VSTR = 160, LDS_KOFF = 0, LDS_VOFF = 256 * KSTR, LDS_OSC = 81920;
__device__ __forceinline__ s16x4 vtr(const LAS unsigned char* p) { return __builtin_amdgcn_ds_read_tr16_b64_v4i16((LAS s16x4*)p); }
struct AttBlk { int dl, r, n, g; };
__device__ __forceinline__ AttBlk att_decode(int bi, int sp) { AttBlk k; k.g = bi >> 4; const int j = bi & 15; k.dl = 1 << (2 * k.g);
    k.r = (k.g == 0) ? 0 : (k.g == 1 ? (j >> 2) : j); k.n = (k.g == 0) ? 16 * sp + j : (k.g == 1 ? 4 * sp + (j & 3) : sp); return k; }
__device__ __forceinline__ void att_prefetch(const bf16* Q, const bf16* K, const bf16* V, size_t headoff, int b, int h, int sp, int bi, int skk, int spart, int w, int fr, int fq,
                                             v4u (&pk)[4], v4u (&pv)[4], bf16x8& q0, bf16x8& q1, const bf16* O, const float* LSE, v4u (&op)[2], float& lp) {
    const AttBlk k = att_decode(bi, sp);
    const unsigned char* Kb = (const unsigned char*)(K + headoff); const unsigned char* Vb = (const unsigned char*)(V + headoff);
    const int tok0 = ((k.n - 1) * 128) * k.dl + k.r;
#pragma unroll
    for (int i = 0; i < 4; ++i) { const int kk = skk + 64 * i; int tok = tok0 + kk * k.dl; tok = tok < 0 ? 0 : tok;
        const unsigned off = (unsigned)tok * (HD * 2) + (unsigned)spart * 16u; pk[i] = *(const v4u*)(Kb + off); pv[i] = *(const v4u*)(Vb + off); }
    const unsigned char* Qb = (const unsigned char*)(Q + (size_t)b * SEQ * D + h * HD); const unsigned char* Ob = (const unsigned char*)(O + (size_t)b * SEQ * D + h * HD);
    const float* Lb = LSE + (size_t)(b * NH + h) * SEQ;
    const int t0 = (128 * k.n + 16 * w) * k.dl + k.r;
    const unsigned qt = (unsigned)(t0 + fr * k.dl);
    const unsigned qoff = qt * (D * 2) + (unsigned)fq * 16u;
    q0 = *(const bf16x8*)(Qb + qoff); q1 = *(const bf16x8*)(Qb + qoff + 64);
    lp = Lb[qt];
    const int lane_ = fr + 16 * fq;
#pragma unroll
    for (int i = 0; i < 2; ++i) { const unsigned ot = (unsigned)(t0 + ((lane_ >> 3) + 8 * i) * k.dl); op[i] = *(const v4u*)(Ob + ot * (D * 2) + (unsigned)(lane_ & 7) * 16u); }
}
template <int MODE> __device__ __forceinline__ void att_block(const bf16* Q, const bf16* K, const bf16* V, bf16* O, float* LSE, LAS unsigned char* lds, size_t headoff, float slope2, int b, int h, int sp, int bi,
                                          int skk, int spart, int w, int fr, int fq, v4u (&pk)[4], v4u (&pv)[4], bf16x8& qa, bf16x8& qb, v4u (&opn)[2], float& lpn) {
    const AttBlk k = att_decode(bi, sp);
    const int dl = k.dl, r = k.r, n = k.n, g = k.g;
    asm volatile("s_waitcnt vmcnt(12)" ::: "memory");
    __syncthreads();
    const int uq = 16 * w + fr;
    const size_t qrow = (size_t)b * SEQ + (size_t)(128 * n + uq) * dl + r;
    float lse_prev = lpn; unsigned long long oprev[4];
    LAS unsigned char* osc = lds + LDS_OSC + w * 2304;
    const int lane_ = fr + 16 * fq;
#pragma unroll
    for (int i = 0; i < 2; ++i) *(LAS v4u*)(osc + ((lane_ >> 3) + 8 * i) * 144 + (lane_ & 7) * 16) = opn[i];
#pragma unroll
    for (int dt = 0; dt < 4; ++dt) oprev[dt] = *(const LAS unsigned long long*)(osc + fr * 144 + 32 * dt + 8 * fq);
#pragma unroll
    for (int i = 0; i < 4; ++i) { const int kk = skk + 64 * i; const bool z = (n == 0) && (i < 2);
        const v4u kz = z ? (v4u){0u, 0u, 0u, 0u} : pk[i], vz = z ? (v4u){0u, 0u, 0u, 0u} : pv[i];
        *(LAS v4u*)(lds + LDS_KOFF + kk * KSTR + spart * 16) = kz; *(LAS v4u*)(lds + LDS_VOFF + kk * VSTR + spart * 16) = vz; }
    const bf16x8 q0 = qa, q1 = qb;
    __syncthreads();
    att_prefetch(Q, K, V, headoff, b, h, sp, (bi + 2 < 48) ? bi + 2 : 47, skk, spart, w, fr, fq, pk, pv, qa, qb, O, LSE, opn, lpn);
    float l_run = 0.f; f32x4 oacc[4]; float m_run = 0.f;
#pragma unroll
    for (int dt = 0; dt < 4; ++dt) oacc[dt] = (f32x4){0.f, 0.f, 0.f, 0.f};
    if (MODE & 1) {
    const float bsl = slope2 * (float)dl;
    const float c0 = -bsl * (float)(fr + 128 - 4 * fq); const f32x4 B0 = (f32x4){c0, c0 + bsl, c0 + 2.f * bsl, c0 + 3.f * bsl};
    f32x4 sv[9];
    {
        const LAS unsigned char* kbase = lds + LDS_KOFF + (16 * w + fr) * KSTR + 16 * fq;
        bf16x8 kf[3][2];
#pragma unroll
        for (int bt = 0; bt < 3; ++bt) {
#pragma unroll
            for (int t = 0; t < 3; ++t) { kf[t][0] = *(const LAS bf16x8*)(kbase + (16 * (3 * bt + t)) * KSTR); kf[t][1] = *(const LAS bf16x8*)(kbase + (16 * (3 * bt + t)) * KSTR + 64); }
            __builtin_amdgcn_sched_barrier(0);
#pragma unroll
            for (int t = 0; t < 3; ++t) { f32x4 acc0 = B0;
                acc0 = __builtin_amdgcn_mfma_f32_16x16x32_bf16(kf[t][0], q0, acc0, 0, 0, 0); acc0 = __builtin_amdgcn_mfma_f32_16x16x32_bf16(kf[t][1], q1, acc0, 0, 0, 0);
                sv[3 * bt + t] = acc0; }
            __builtin_amdgcn_sched_barrier(0);
        }
    }
#pragma unroll
    for (int v = 0; v < 4; ++v) { if (4 * fq + v < fr) sv[0][v] = -INFINITY; if (4 * fq + v > fr) sv[8][v] = -INFINITY; }
    float tj[9];
#pragma unroll
    for (int jj = 0; jj < 9; ++jj) tj[jj] = (n == 0 && w + jj < 8) ? -INFINITY : bsl * (float)(16 * jj);
    float mloc = -INFINITY;
#pragma unroll
    for (int jj = 0; jj < 9; ++jj) mloc = fmaxf(mloc, fmaxf(fmaxf(sv[jj][0], sv[jj][1]), fmaxf(sv[jj][2], sv[jj][3])) + tj[jj]);
    mloc = fmaxf(mloc, __shfl_xor(mloc, 16)); mloc = fmaxf(mloc, __shfl_xor(mloc, 32));
    m_run = mloc;
    unsigned pw[10][2];
#pragma unroll
    for (int jj = 0; jj < 9; ++jj) { float pe[4]; const float dj = tj[jj] - mloc;
#pragma unroll
        for (int v = 0; v < 4; ++v) { pe[v] = __builtin_amdgcn_exp2f(sv[jj][v] + dj); l_run += pe[v]; }
        pw[jj][0] = pg8::cvt_pk_bf16(pe[0], pe[1]); pw[jj][1] = pg8::cvt_pk_bf16(pe[2], pe[3]); }
    pw[9][0] = 0u; pw[9][1] = 0u;
    {
        const LAS unsigned char* vbase = lds + LDS_VOFF + (16 * w + 4 * fq + (fr >> 2)) * VSTR + (4 * (fr & 3)) * 2;
        s16x4 vf[4][2], vn[4][2];
#pragma unroll
        for (int dt = 0; dt < 4; ++dt) { vf[dt][0] = vtr(vbase + 32 * dt); vf[dt][1] = vtr(vbase + 32 * dt + 16 * VSTR); }
#pragma unroll
        for (int pp = 0; pp < 5; ++pp) {
            if (pp < 4) {
#pragma unroll
                for (int dt = 0; dt < 4; ++dt) { vn[dt][0] = vtr(vbase + 32 * (pp + 1) * VSTR + 32 * dt); vn[dt][1] = vtr(vbase + 32 * (pp + 1) * VSTR + 32 * dt + 16 * VSTR); }
            }
            __builtin_amdgcn_sched_barrier(0);
            const v4u pq = (v4u){pw[2 * pp][0], pw[2 * pp][1], pw[2 * pp + 1][0], pw[2 * pp + 1][1]};
            const bf16x8 pfrag = __builtin_bit_cast(bf16x8, pq);
#pragma unroll
            for (int dt = 0; dt < 4; ++dt) {
                const bf16x8 af = (bf16x8){vf[dt][0][0], vf[dt][0][1], vf[dt][0][2], vf[dt][0][3], vf[dt][1][0], vf[dt][1][1], vf[dt][1][2], vf[dt][1][3]};
                oacc[dt] = __builtin_amdgcn_mfma_f32_16x16x32_bf16(af, pfrag, oacc[dt], 0, 0, 0);
            }
            __builtin_amdgcn_sched_barrier(0);
            if (pp < 4) {
#pragma unroll
                for (int dt = 0; dt < 4; ++dt) { vf[dt][0] = vn[dt][0]; vf[dt][1] = vn[dt][1]; }
            }
        }
    }
    } else { l_run = 1.f; }
    float l = l_run; l += __shfl_xor(l, 16); l += __shfl_xor(l, 32);
    if (g == 0) { lse_prev = -INFINITY; oprev[0] = 0ull; oprev[1] = 0ull; oprev[2] = 0ull; oprev[3] = 0ull; }
    const float m_tot = fmaxf(lse_prev, m_run), wp = __builtin_amdgcn_exp2f(lse_prev - m_tot), wcur = __builtin_amdgcn_exp2f(m_run - m_tot);
    const float denom = wp + l * wcur, inv = __builtin_amdgcn_rcpf(denom), cp = wp * inv, cc = wcur * inv;
#pragma unroll
    for (int dt = 0; dt < 4; ++dt) { const unsigned lo = (unsigned)oprev[dt], hi = (unsigned)(oprev[dt] >> 32); const f32x4 op = (f32x4){bflo(lo), bfhi(lo), bflo(hi), bfhi(hi)};
        const f32x4 o = op * cp + oacc[dt] * cc; v2u ov; ov.x = pg8::cvt_pk_bf16(o[0], o[1]); ov.y = pg8::cvt_pk_bf16(o[2], o[3]);
        *(LAS v2u*)(osc + fr * 144 + 32 * dt + 8 * fq) = ov; }
#pragma unroll
    for (int i = 0; i < 2; ++i) { const v4u rowv = *(const LAS v4u*)(osc + ((lane_ >> 3) + 8 * i) * 144 + (lane_ & 7) * 16);
        const size_t orow = (size_t)b * SEQ + (size_t)(128 * n + 16 * w + (lane_ >> 3) + 8 * i) * dl + r; *(v4u*)(O + orow * D + h * HD + (lane_ & 7) * 8) = rowv; }
    if (fq == 0) LSE[(size_t)(b * NH + h) * SEQ + (qrow - (size_t)b * SEQ)] = m_tot + __builtin_amdgcn_logf(denom);
}
template <int MODE> __device__ __forceinline__ void attn_fast(const bf16* Q, const bf16* K, const bf16* V, bf16* O, float* LSE, LAS unsigned char* lds, int bid, int G, int tid) {
    const int lane = tid & 63, w = __builtin_amdgcn_readfirstlane(tid >> 6), fr = lane & 15, fq = lane >> 4;
    for (int i = tid; i < 16 * VSTR / 4; i += NT) ((LAS unsigned*)(lds + LDS_VOFF + 256 * VSTR))[i] = 0u;
    const int skk = tid >> 3, spart = tid & 7;
    for (int uid_ = bid; uid_ < 256; uid_ += G) { const int uid = (((uid_ & 7) << 5) | ((uid_ & 255) >> 3));
        const int b = uid >> 6, h = (uid >> 2) & 15, sp = uid & 3;
        const float slope2 = exp2f(-0.5f * (float)(h + 1)) * 1.4426950408889634f;
        const size_t headoff = (size_t)(b * NH + h) * SEQ * HD;
        v4u pkA[4], pvA[4], pkB[4], pvB[4]; bf16x8 qA0, qA1, qB0, qB1; v4u opA[2], opB[2]; float lpA, lpB;
        att_prefetch(Q, K, V, headoff, b, h, sp, 0, skk, spart, w, fr, fq, pkA, pvA, qA0, qA1, O, LSE, opA, lpA);
        att_prefetch(Q, K, V, headoff, b, h, sp, 1, skk, spart, w, fr, fq, pkB, pvB, qB0, qB1, O, LSE, opB, lpB);
#pragma unroll 1
        for (int bi = 0; bi < 48; bi += 2) {
            att_block<MODE>(Q, K, V, O, LSE, lds, headoff, slope2, b, h, sp, bi, skk, spart, w, fr, fq, pkA, pvA, qA0, qA1, opA, lpA);
            att_block<MODE>(Q, K, V, O, LSE, lds, headoff, slope2, b, h, sp, bi + 1, skk, spart, w, fr, fq, pkB, pvB, qB0, qB1, opB, lpB);
        }
        asm volatile("s_waitcnt vmcnt(0)" ::: "memory");
        __syncthreads();
    }
}

#define XB_TMO      128
#define XB_XCNT(j)  (256  + 64 * (j))
#define XB_XSUB(j)  (1280 + 64 * (j))
#define XB_XGEN(j)  (2304 + 64 * (j))
#define XB_TOP      3328
#define XB_TOPGEN   3392
#define XCD_BAR_WORDS 3456
#define XB_SPIN_CAP (1u << 22)
__device__ __forceinline__ unsigned xb_ld(unsigned* p)              { return __hip_atomic_load(p, __ATOMIC_RELAXED, __HIP_MEMORY_SCOPE_AGENT); }
__device__ __forceinline__ unsigned xb_add(unsigned* p, unsigned v) { return __hip_atomic_fetch_add(p, v, __ATOMIC_RELAXED, __HIP_MEMORY_SCOPE_AGENT); }
__device__ __forceinline__ unsigned xb_xcc_id() { return (unsigned)__builtin_amdgcn_s_getreg((3 << 11) | 20) & 0xFu; }
#define XB_SPIN(cond, bar) do { unsigned _sp = 0; while (cond) { __builtin_amdgcn_s_sleep(1); \
    if ((++_sp & 255u) == 0u) { if (xb_ld(&(bar)[XB_TMO])) break; if (_sp > XB_SPIN_CAP) { atomicAdd(&(bar)[XB_TMO], 1u); break; } } } } while (0)
struct XcdBarrier { unsigned* bar; unsigned x; volatile LAS unsigned* st; };
__device__ __forceinline__ XcdBarrier xcd_barrier_post(unsigned* bar, volatile LAS unsigned* st) {
    XcdBarrier b; b.bar = bar; b.x = xb_xcc_id(); b.st = st;
    if (threadIdx.x == 0) (void)xb_add(&bar[XB_XCNT(b.x)], 1u);
    return b;
}
__device__ __forceinline__ void xcd_barrier_complete(unsigned* bar, unsigned x, unsigned& nloc, unsigned& nx) {
    const unsigned G = gridDim.x * gridDim.y * gridDim.z;
    unsigned sum, cnt, mine, sp = 0u;
    for (;;) {
        sum = 0u; cnt = 0u; mine = 0u;
#pragma unroll
        for (unsigned j = 0; j < 16; ++j) { const unsigned c = xb_ld(&bar[XB_XCNT(j)]); sum += c; cnt += (c > 0u) ? 1u : 0u; mine = (j == x) ? c : mine; }
        if (sum == G) break;
        __builtin_amdgcn_s_sleep(1);
        if ((++sp & 255u) == 0u) { if (xb_ld(&bar[XB_TMO])) break; if (sp > XB_SPIN_CAP) { atomicAdd(&bar[XB_TMO], 1u); break; } }
    }
    nloc = mine > 0u ? mine : 1u; nx = cnt > 0u ? cnt : 1u;
}
__device__ __forceinline__ void xcd_barrier(const XcdBarrier& b) {
    asm volatile("s_waitcnt vmcnt(0)" ::: "memory");
    __syncthreads();
    if (threadIdx.x == 0) {
        unsigned* bar = b.bar;
        __builtin_amdgcn_s_waitcnt(0);
        unsigned nloc = b.st[0], nx = b.st[1];
        if (nloc == 0u) { xcd_barrier_complete(bar, b.x, nloc, nx); b.st[0] = nloc; b.st[1] = nx; }
        const unsigned old = xb_add(&bar[XB_XSUB(b.x)], 1u);
        const unsigned gen = old / nloc;
        if (old + 1u == (gen + 1u) * nloc) {
            __builtin_amdgcn_fence(__ATOMIC_RELEASE, "agent");
            asm volatile("s_waitcnt vmcnt(0)" ::: "memory");
            const unsigned og = xb_add(&bar[XB_TOP], 1u);
            const unsigned tg = og / nx;
            if (og + 1u == (tg + 1u) * nx) xb_add(&bar[XB_TOPGEN], 1u);
            else XB_SPIN(xb_ld(&bar[XB_TOPGEN]) == tg, bar);
            __builtin_amdgcn_fence(__ATOMIC_ACQUIRE, "agent");
            xb_add(&bar[XB_XGEN(b.x)], 1u);
            asm volatile("s_waitcnt vmcnt(0)" ::: "memory");
        } else {
            XB_SPIN(xb_ld(&bar[XB_XGEN(b.x)]) == gen, bar);
            __builtin_amdgcn_fence(__ATOMIC_ACQUIRE, "agent");
            asm volatile("s_waitcnt vmcnt(0)" ::: "memory");
        }
    }
    __syncthreads();
}

__global__ void __launch_bounds__(NT, 2) fwd_kernel(Args a) {
    extern __shared__ __attribute__((aligned(16))) unsigned char lds_raw[];
    LAS unsigned char* lds = (LAS unsigned char*)lds_raw;
    cg::grid_group grid = cg::this_grid();
    const int G = gridDim.x, bid = blockIdx.x;
    if (threadIdx.x < 64) ((LAS unsigned*)(lds + 131072))[threadIdx.x] = 0u;
    __syncthreads();
    const XcdBarrier xbar = xcd_barrier_post((unsigned*)(a.ws + WS_CTL) + 4096, (volatile LAS unsigned*)(lds + 131072) + 8);
#define GSYNC() xcd_barrier(xbar)
#define PHASE_VARS() unsigned char* ws = opq(a.ws); float* out = opq(a.out); const int tid = opqv((int)threadIdx.x), lane = tid & 63, wave = __builtin_amdgcn_readfirstlane(tid >> 6); \
    const int gw = bid * NWAVES + wave, NGW = G * NWAVES; bf16* XN = (bf16*)(ws + WS_XN); LAS float* scr = (LAS float*)(lds + wave * 16384); (void)out; (void)lane; (void)gw; (void)NGW; (void)XN; (void)scr;

    {
        PHASE_VARS();
        { v4u* xbz = (v4u*)(ws + WS_XB); for (int i = bid * NT + tid; i < (int)(4 * MiB / 16); i += G * NT) xbz[i] = (v4u){0u, 0u, 0u, 0u}; }
        convert_layer(a, 0, ws + WS_W0, scr, gw, NGW, lane);
        const float* x = opq(a.in[0]);
        for (int m = gw; m < M; m += 2 * NGW) {
            const f32x4* xa = (const f32x4*)(x + (size_t)m * D) + lane; const f32x4* xb = (const f32x4*)(x + (size_t)(m + NGW) * D) + lane;
            f32x4 va[4], vb[4]; float sa = 0.f, sb = 0.f;
#pragma unroll
            for (int j = 0; j < 4; ++j) { va[j] = xa[64 * j]; vb[j] = xb[64 * j]; }
#pragma unroll
            for (int j = 0; j < 4; ++j) { sa += (va[j].x * va[j].x + va[j].y * va[j].y) + (va[j].z * va[j].z + va[j].w * va[j].w); sb += (vb[j].x * vb[j].x + vb[j].y * vb[j].y) + (vb[j].z * vb[j].z + vb[j].w * vb[j].w); }
            const float ia = sqrtf(wave_sum(sa) * (1.f / D) + EPS), ib = sqrtf(wave_sum(sb) * (1.f / D) + EPS), ra = 1.f / ia, rb = 1.f / ib;
            if (lane == 0) { float* invB = (float*)(ws + WS_INV) + M; invB[m] = ia; invB[m + NGW] = ib; }
            unsigned long long* oa = (unsigned long long*)(XN + (size_t)m * D) + lane; unsigned long long* ob = (unsigned long long*)(XN + (size_t)(m + NGW) * D) + lane;
#pragma unroll
            for (int j = 0; j < 4; ++j) { oa[64 * j] = (unsigned long long)pk2(va[j].x * ra, va[j].y * ra) | ((unsigned long long)pk2(va[j].z * ra, va[j].w * ra) << 32);
                ob[64 * j] = (unsigned long long)pk2(vb[j].x * rb, vb[j].y * rb) | ((unsigned long long)pk2(vb[j].z * rb, vb[j].w * rb) << 32); }
        }
    }
    grid.sync();

#pragma unroll 1
    for (int l = 0; l < DEPTH; ++l) {
        const bool isA = l < 2;
        {
            unsigned char* ws = opq(a.ws); unsigned char* wl = ws + ((l & 1) ? WS_W1 : WS_W0);
            const int N1 = (l == 3) ? D : 3 * D;
            pg8::Gemm g{(const bf16*)(ws + WS_XN), (const bf16*)(wl + WO_1), M, N1, D}; pg8::StaticOrder S; S.init(M, N1, G, bid);
            pg8::EpiBf16 E;
            E.O2 = (bf16*)(ws + WS_KV); E.cmul = isA ? 1 : 0;
            if (isA) { E.O = (bf16*)(ws + WS_G); E.ldc = D; E.split_cols = 0; E.split_stride = 0; E.hm = 0; }
            else if (l == 2) { E.O = (bf16*)(ws + WS_KV); E.ldc = D; E.split_cols = D; E.split_stride = (size_t)M * D; E.hm = 1; }
            else { E.O = (bf16*)(ws + WS_H); E.ldc = D; E.split_cols = 0; E.split_stride = 0; E.hm = 0; }
            pg8::gemm_phase<pg8::EpiBf16, pg8::StaticOrder, true, true>(lds, g, S, E);
        }
        GSYNC();
        {
            PHASE_VARS();
            if (isA) conv_phase((const bf16*)(ws + WS_G), (const bf16*)(ws + WS_KV), opq(a.in[3]) + (size_t)l * 3 * D, (bf16*)(ws + WS_H), bid, G, tid);
            else attn_fast<15>((const bf16*)(ws + WS_H), (const bf16*)(ws + WS_KV), (const bf16*)(ws + WS_KV + 64 * MiB), (bf16*)(ws + WS_H + 64 * MiB), (float*)(ws + WS_LSE), lds, bid, G, tid);
            __syncthreads();
            if (l + 1 < DEPTH) convert_layer(a, l + 1, ws + ((l & 1) ? WS_W0 : WS_W1), scr, gw, NGW, lane);
        }
        GSYNC();
#pragma unroll 1
        for (int round = 0; round < 2; ++round) {
            unsigned char* ws = opq(a.ws); unsigned char* wl = ws + ((l & 1) ? WS_W1 : WS_W0);
            pg8::Gemm g{isA ? (const bf16*)(ws + WS_H) : (const bf16*)(ws + WS_H + 64 * MiB), (const bf16*)(wl + WO_3), M, D, D};
            pg8::RoundOrder S; S.so.init(M, D, G, bid); S.round = round;
            unsigned long long* xb = (unsigned long long*)(ws + WS_XB);
            pg8::EpiRmsResRms E; E.base = nullptr; E.out = opq(a.out); E.xn = (bf16*)(ws + WS_XN); E.gain = opq(a.in[1]) + (size_t)l * 4 * D + D; E.write_xn = 1; E.write_out = 0;
            E.inv_in = (const float*)(ws + WS_INV) + M; E.inv_out = (float*)(ws + WS_INV);
            E.st1.xbuf = xb; E.st1.tag = (unsigned)(l + 1);
            E.st2.xbuf = xb + (size_t)M * 4; E.st2.tag = (unsigned)(l + 1);
            pg8::gemm_phase<pg8::EpiRmsResRms, pg8::RoundOrder, false, true>(lds, g, S, E);
            __syncthreads();
        }
        GSYNC();
        {
            unsigned char* ws = opq(a.ws); unsigned char* wl = ws + ((l & 1) ? WS_W1 : WS_W0);
            pg8::Gemm g{(const bf16*)(ws + WS_XN), (const bf16*)(wl + WO_FI), M, 2 * FF, D}; pg8::StaticOrder S; S.init(M, 2 * FF, G, bid);
            pg8::EpiSwiGLU E; E.O = (bf16*)(ws + WS_H); E.ldc = FF;
            pg8::gemm_phase<pg8::EpiSwiGLU, pg8::StaticOrder, true, true>(lds, g, S, E);
        }
        GSYNC();
#pragma unroll 1
        for (int round = 0; round < 2; ++round) {
            unsigned char* ws = opq(a.ws); unsigned char* wl = ws + ((l & 1) ? WS_W1 : WS_W0);
            pg8::Gemm g{(const bf16*)(ws + WS_H), (const bf16*)(wl + WO_FO), M, D, FF};
            pg8::RoundOrder S; S.so.init(M, D, G, bid); S.round = round;
            unsigned long long* xb = (unsigned long long*)(ws + WS_XB) + (size_t)M * 8;
            pg8::EpiRmsResRms E; E.base = nullptr; E.out = opq(a.out); E.xn = (bf16*)(ws + WS_XN); E.gain = opq(a.in[1]) + (size_t)l * 4 * D + 3 * D; E.write_xn = (l + 1 < DEPTH) ? 1 : 0; E.write_out = (l + 1 < DEPTH) ? 0 : 1;
            E.inv_in = (const float*)(ws + WS_INV); E.inv_out = (float*)(ws + WS_INV) + M;
            E.st1.xbuf = xb; E.st1.tag = (unsigned)(l + 1);
            E.st2.xbuf = xb + (size_t)M * 4; E.st2.tag = (unsigned)(l + 1);
            pg8::gemm_phase<pg8::EpiRmsResRms, pg8::RoundOrder, false, true>(lds, g, S, E);
            __syncthreads();
        }
        if (l + 1 < DEPTH) GSYNC();
    }
}

extern "C" void kernel_launch(void* const* d_in, const int* in_sizes, int n_in, void* d_out, int out_size, void* d_ws, size_t ws_size, hipStream_t stream) {
    static int grid = 0;
    if (grid == 0) {
        if (n_in != 11 || ws_size < WS_END) { fprintf(stderr, "kernel_launch: unexpected n_in %d / ws_size %zu\n", n_in, ws_size); grid = -1; return; }
        int dev = 0, cus = 0, per_cu = 0;
        hipGetDevice(&dev);
        hipDeviceGetAttribute(&cus, hipDeviceAttributeMultiprocessorCount, dev);
        hipFuncSetAttribute((const void*)fwd_kernel, hipFuncAttributeMaxDynamicSharedMemorySize, LDS_BYTES);
        if (hipOccupancyMaxActiveBlocksPerMultiprocessor(&per_cu, (const void*)fwd_kernel, NT, LDS_BYTES) != hipSuccess || per_cu < 1) per_cu = 1;
        (void)hipGetLastError();
        grid = cus * per_cu;
        if (grid >= 256) grid = 256;
    }
    if (grid < 0) return;
    if (hipMemsetAsync((char*)d_ws + WS_CTL, 0, 64 * 1024, stream) != hipSuccess) { fprintf(stderr, "memset failed\n"); return; }
    Args a{};
    for (int i = 0; i < 11; ++i) a.in[i] = (const float*)d_in[i];
    a.out = (float*)d_out; a.ws = (unsigned char*)d_ws;
    void* args[] = {&a};
    hipError_t e = hipLaunchCooperativeKernel((const void*)fwd_kernel, dim3(grid), dim3(NT), args, LDS_BYTES, stream);
    if (e != hipSuccess) fprintf(stderr, "cooperative launch failed: %s (grid %d)\n", hipGetErrorString(e), grid);
}
```
